# Optimizing an MI355X kernel written in HIP

```python
import math
import jax, jax.numpy as jnp
from jax import lax
import numpy as np

D_MODEL = 1024
BATCH = 16
SEQ = 2048
DEPTH = 2

HEAD_DIM = 64
N_HEADS_FOX = 8
N_HEADS_SB = 8
DIL_PATTERNS = ((128, 1), (512, 4), (2048, 16))
N_DIL_GROUPS = len(DIL_PATTERNS)
N_HEADS_DIL = 4
D_FF = 4 * D_MODEL
ROPE_THETA = 10000.0
Q_BLOCK = 128
EPS = 1e-6
N_BRANCHES = 3

W_FOX = N_HEADS_FOX * HEAD_DIM
W_SB = N_HEADS_SB * HEAD_DIM
W_DIL = N_HEADS_DIL * HEAD_DIM
SZ_FOX_QKV = 3 * W_FOX
SZ_FORGET = N_HEADS_FOX
SZ_SB_QKV = 3 * W_SB
SZ_DIL_QKV = 3 * N_DIL_GROUPS * W_DIL
SZ_GATES = N_BRANCHES * D_MODEL
D_IN = SZ_FOX_QKV + SZ_FORGET + SZ_SB_QKV + SZ_DIL_QKV + SZ_GATES

kernel_name = "gated_parallel_fox_stickbreak_dilated"


def rms_norm(x, g):
    xf = x.astype(jnp.float32)
    y = xf * lax.rsqrt(jnp.mean(xf * xf, axis=-1, keepdims=True) + EPS)
    return (y * g.astype(jnp.float32)).astype(x.dtype)


def rope(x, positions):
    half = x.shape[-1] // 2
    inv = 1.0 / (ROPE_THETA ** (jnp.arange(half, dtype=jnp.float32) / half))
    ang = positions.astype(jnp.float32)[..., None] * inv
    cos = jnp.cos(ang)[:, :, None, :]
    sin = jnp.sin(ang)[:, :, None, :]
    xf = x.astype(jnp.float32)
    x1, x2 = xf[..., :half], xf[..., half:]
    return jnp.concatenate([x1 * cos - x2 * sin, x2 * cos + x1 * sin], axis=-1).astype(x.dtype)


def forgetting_attention(q, k, v, f_cum):
    B, T, H, D = q.shape
    scale = 1.0 / math.sqrt(D)
    f_t = jnp.transpose(f_cum, (0, 2, 1))
    outs = []
    for i in range(T // Q_BLOCK):
        lo, hi = i * Q_BLOCK, (i + 1) * Q_BLOCK
        s = jnp.einsum('bqhd,bkhd->bhqk', q[:, lo:hi], k[:, :hi]).astype(jnp.float32) * scale
        s = s + f_t[:, :, lo:hi, None] - f_t[:, :, None, :hi]
        mask = (lo + np.arange(Q_BLOCK))[:, None] >= np.arange(hi)[None, :]
        s = jnp.where(mask, s, -jnp.inf)
        p = jax.nn.softmax(s, axis=-1).astype(v.dtype)
        outs.append(jnp.einsum('bhqk,bkhd->bqhd', p, v[:, :hi]))
    return jnp.concatenate(outs, axis=1)


def stick_breaking_attention(q, k, v):
    B, T, H, D = q.shape
    scale = 1.0 / math.sqrt(D)
    outs = []
    for i in range(T // Q_BLOCK):
        lo, hi = i * Q_BLOCK, (i + 1) * Q_BLOCK
        z = jnp.einsum('bqhd,bkhd->bhqk', q[:, lo:hi], k[:, :hi]).astype(jnp.float32) * scale
        mask = (lo + np.arange(Q_BLOCK))[:, None] > np.arange(hi)[None, :]
        log_not = jnp.where(mask, jax.nn.log_sigmoid(-z), 0.0)
        later = lax.cumsum(log_not, axis=3, reverse=True) - log_not
        a = jnp.where(mask, jnp.exp(jax.nn.log_sigmoid(z) + later), 0.0)
        outs.append(jnp.einsum('bhqk,bkhd->bqhd', a.astype(v.dtype), v[:, :hi]))
    return jnp.concatenate(outs, axis=1)


def dilated_window_attention(q, k, v, window, dilation):
    B, T, H, D = q.shape
    n = T // dilation
    W = window // dilation
    Z = B * dilation
    scale = 1.0 / math.sqrt(D)

    def to_streams(a):
        return a.reshape(B, n, dilation, H, D).transpose(0, 2, 1, 3, 4).reshape(Z, n, H, D)

    qs, ks, vs = to_streams(q), to_streams(k), to_streams(v)
    qb = math.gcd(n, Q_BLOCK)
    nb = n // qb
    pad = ((0, 0), (W, 0), (0, 0), (0, 0))
    kp, vp = jnp.pad(ks, pad), jnp.pad(vs, pad)
    idx = np.arange(nb)[:, None] * qb + np.arange(qb + W)[None, :]
    kblk, vblk = kp[:, idx], vp[:, idx]
    qblk = qs.reshape(Z, nb, qb, H, D)
    s = jnp.einsum('znqhd,znkhd->znhqk', qblk, kblk).astype(jnp.float32) * scale
    dist = np.arange(qb)[:, None] + W - np.arange(qb + W)[None, :]
    band = (dist >= 0) & (dist <= W)
    mask = band[None] & (idx - W >= 0)[:, None, :]
    s = jnp.where(mask[None, :, None], s, -jnp.inf)
    m = jnp.max(s, axis=-1, keepdims=True)
    p = jnp.exp(s - m)
    den = jnp.sum(p, axis=-1, keepdims=True)
    o = jnp.einsum('znhqk,znkhd->znqhd', (p / den).astype(v.dtype), vblk)
    lse = jnp.transpose((m + jnp.log(den))[..., 0], (0, 1, 3, 2))
    o = o.reshape(B, dilation, n, H, D).transpose(0, 2, 1, 3, 4).reshape(B, T, H, D)
    lse = lse.reshape(B, dilation, n, H).transpose(0, 2, 1, 3).reshape(B, T, H)
    return o, lse


def setup_inputs(seed: int = 0) -> dict:
    key = jax.random.key(seed)
    ks = jax.random.split(key, 17)
    f32 = jnp.float32

    def nrm(k, shape, fan_in, mult=1.0):
        return jax.random.normal(k, shape, f32) * (mult * fan_in ** -0.5)

    def gain(k, shape):
        return 1.0 + 0.05 * jax.random.normal(k, shape, f32)

    x = jax.random.normal(ks[0], (BATCH, SEQ, D_MODEL), f32)
    positions = jnp.broadcast_to(jnp.arange(SEQ, dtype=jnp.int32), (BATCH, SEQ))
    return {
        "x": x,
        "positions": positions,
        "attn_norm": gain(ks[1], (DEPTH, D_MODEL)),
        "w_in": nrm(ks[2], (DEPTH, D_MODEL, D_IN), D_MODEL),
        "b_forget": 2.0 + 0.1 * jax.random.normal(ks[3], (DEPTH, N_HEADS_FOX), f32),
        "q_norm_fox": gain(ks[4], (DEPTH, HEAD_DIM)),
        "k_norm_fox": gain(ks[5], (DEPTH, HEAD_DIM)),
        "q_norm_dil": gain(ks[6], (DEPTH, HEAD_DIM)),
        "k_norm_dil": gain(ks[7], (DEPTH, HEAD_DIM)),
        "w_up_fox": nrm(ks[8], (DEPTH, W_FOX, D_MODEL), W_FOX),
        "w_up_sb": nrm(ks[9], (DEPTH, W_SB, D_MODEL), W_SB),
        "w_up_dil": nrm(ks[10], (DEPTH, W_DIL, D_MODEL), W_DIL),
        "w_out": nrm(ks[11], (DEPTH, D_MODEL, D_MODEL), D_MODEL),
        "mlp_norm": gain(ks[12], (DEPTH, D_MODEL)),
        "w_mlp_in": nrm(ks[13], (DEPTH, D_MODEL, D_FF), D_MODEL),
        "w_mlp_out": nrm(ks[14], (DEPTH, D_FF, D_MODEL), D_FF, 0.5),
    }


def reference(x, positions, attn_norm, w_in, b_forget, q_norm_fox, k_norm_fox, q_norm_dil, k_norm_dil,
              w_up_fox, w_up_sb, w_up_dil, w_out, mlp_norm, w_mlp_in, w_mlp_out):
    B, T, _ = x.shape
    o1 = SZ_FOX_QKV
    o2 = o1 + SZ_FORGET
    o3 = o2 + SZ_SB_QKV
    o4 = o3 + SZ_DIL_QKV
    for l in range(DEPTH):
        h = rms_norm(x, attn_norm[l])
        proj = h @ w_in[l]

        fox = proj[..., :o1].reshape(B, T, 3, N_HEADS_FOX, HEAD_DIM)
        qa = rms_norm(fox[:, :, 0], q_norm_fox[l])
        ka = rms_norm(fox[:, :, 1], k_norm_fox[l])
        va = fox[:, :, 2]
        log_f = jax.nn.log_sigmoid(proj[..., o1:o2].astype(jnp.float32) + b_forget[l].astype(jnp.float32))
        f_cum = jnp.cumsum(log_f, axis=1)
        out_a = forgetting_attention(qa, ka, va, f_cum)

        sb = proj[..., o2:o3].reshape(B, T, 3, N_HEADS_SB, HEAD_DIM)
        out_b = stick_breaking_attention(sb[:, :, 0], sb[:, :, 1], sb[:, :, 2])

        dil = proj[..., o3:o4].reshape(B, T, 3, N_DIL_GROUPS * N_HEADS_DIL, HEAD_DIM)
        qc = rope(rms_norm(dil[:, :, 0], q_norm_dil[l]), positions)
        kc = rope(rms_norm(dil[:, :, 1], k_norm_dil[l]), positions)
        vc = dil[:, :, 2]
        group_o, group_lse = [], []
        for g, (window, dilation) in enumerate(DIL_PATTERNS):
            sl = slice(g * N_HEADS_DIL, (g + 1) * N_HEADS_DIL)
            o_g, lse_g = dilated_window_attention(qc[:, :, sl], kc[:, :, sl], vc[:, :, sl], window, dilation)
            group_o.append(o_g)
            group_lse.append(lse_g)
        wts = jax.nn.softmax(jnp.stack(group_lse, axis=0), axis=0)
        out_c = jnp.sum(wts[..., None].astype(vc.dtype) * jnp.stack(group_o, axis=0), axis=0)

        gates = jax.nn.sigmoid(proj[..., o4:].astype(jnp.float32)).astype(x.dtype).reshape(B, T, N_BRANCHES, D_MODEL)
        y_a = out_a.reshape(B, T, W_FOX) @ w_up_fox[l]
        y_b = out_b.reshape(B, T, W_SB) @ w_up_sb[l]
        y_c = out_c.reshape(B, T, W_DIL) @ w_up_dil[l]
        merged = gates[:, :, 0] * y_a + gates[:, :, 1] * y_b + gates[:, :, 2] * y_c
        x = x + merged @ w_out[l]

        h2 = rms_norm(x, mlp_norm[l])
        x = x + jnp.square(jax.nn.relu(h2 @ w_mlp_in[l])) @ w_mlp_out[l]
    return x
```

```cpp
#include <hip/hip_runtime.h>
#include <hip/hip_cooperative_groups.h>
#include <cstdio>
#include <cstdint>
#include <cmath>
namespace cg = cooperative_groups;
constexpr int NWAVES = 8;
constexpr int BATCH = 16, SEQ = 2048, DMODEL = 1024, DEPTH = 2, M = BATCH * SEQ, DIN = 8456, DFF = 4096;
constexpr int NQKV = 5376, NGATE = 3072;
constexpr float EPS = 1e-6f, LOG2E = 1.4426950408889634f, C2 = 0.125f * 1.4426950408889634f;
constexpr size_t KiB = 1024, MiB = 1u << 20;
constexpr size_t WL_QKV = 0, WL_G = 10752 * KiB, WL_A = 16896 * KiB, WL_B = 17920 * KiB, WL_C = 18944 * KiB, WL_O = 19456 * KiB, WL_MI = 21504 * KiB, WL_MO = 29696 * KiB, WL_STRIDE = 38 * MiB;
constexpr size_t WS_W = 0, WS_CTL = 76 * MiB, WS_SSQ = 77 * MiB, WS_LFS = 79 * MiB, WS_LSE = 80 * MiB, WS_CTOT = 81 * MiB + 512 * KiB;
constexpr size_t WS_R0 = 82 * MiB, WS_FOXQ = 146 * MiB, WS_SBQ = 178 * MiB, WS_DILQ = 210 * MiB;
constexpr size_t WS_FOXK = 258 * MiB, WS_FOXV = 290 * MiB, WS_SBK = 322 * MiB, WS_SBV = 354 * MiB, WS_DILK = 386 * MiB, WS_DILV = 434 * MiB;
constexpr size_t WS_GAIN = 81 * MiB + 768 * KiB;
constexpr size_t WS_COS = 498 * MiB, WS_SIN = 502 * MiB;
constexpr size_t WS_GATE = 258 * MiB  , WS_MRG = 322 * MiB  , WS_OC = 482 * MiB, WS_R1 = 146 * MiB, WS_HID = 210 * MiB, WS_END = 506 * MiB;
constexpr int LDS_BYTES = 147456;
constexpr int NPHASE = 1 + 8 * DEPTH;
constexpr int ITEMS_PER_LAYER = 9472;
constexpr int N_ATT_UNITS = 64 * 256 + 16 * 12 * 64;

static_assert(WS_FOXQ == 146 * MiB && WS_SBQ == 178 * MiB && WS_DILQ == 210 * MiB && WS_FOXK == 258 * MiB && WS_SBK == 322 * MiB && WS_DILK == 386 * MiB && WS_FOXV == 290 * MiB && WS_SBV == 354 * MiB && WS_DILV == 434 * MiB, "EpiQKV plane offsets");
static_assert(WS_FOXQ == 146 * MiB && WS_SBQ == 178 * MiB && WS_DILQ == 210 * MiB && WS_FOXK == 258 * MiB && WS_SBK == 322 * MiB && WS_DILK == 386 * MiB && WS_FOXV == 290 * MiB && WS_SBV == 354 * MiB && WS_DILV == 434 * MiB, "EpiQKV plane offsets");
namespace pg8 {
#define PG8_LAS __attribute__((address_space(3)))
typedef unsigned short bf16_t;
typedef short bf16x8 __attribute__((ext_vector_type(8)));
typedef float f32x4 __attribute__((ext_vector_type(4)));
typedef unsigned u32x4 __attribute__((ext_vector_type(4)));
constexpr int BM = 256, BK = 64, HALF = 128, HTB = HALF * BK * 2  , STAGE_BYTES = 8 * HTB, NXCD = 8, WGM = 8;

__host__ __device__ __forceinline__ int lds_byte(int r, int c) { const int st = (r >> 4) * 2 + (c >> 5), rr = r & 15, cc = c & 31, ob = rr * 64 + cc * 2; return st * 1024 + (ob ^ (((ob >> 9) & 1) << 5)); }
__host__ __device__ __forceinline__ void stage_rc(int b, int& R, int& C) { const int st = b / 1024, sb = b % 1024, swz = sb ^ (((sb >> 9) & 1) << 5); R = (st >> 1) * 16 + swz / 64; C = (st & 1) * 32 + (swz % 64) / 2; }
__host__ __device__ __forceinline__ int perm32(int rho) { const int n = rho >> 4, i = rho & 15; return 8 * (i >> 2) + 4 * n + (i & 3); }

struct Unit { int pm, pn, idx; };
struct Gemm { const bf16_t* A; const bf16_t* Bt; int M, N, K; };

struct StaticOrder {
    int nM, nN, nwg, G, c;
    __host__ __device__ void init(int M, int N, int G_, int c_) { nM = M / BM; nN = N / BM; nwg = nM * nN; G = G_; c = c_; }
    __host__ __device__ bool next(int i, Unit& u) const {
        const long L = (long)i * G + c; if (L >= nwg) return false;
        int wgid = (int)L; { const int q = nwg / NXCD, r = nwg % NXCD, xcd = wgid % NXCD, off = wgid / NXCD; wgid = (xcd < r ? xcd * (q + 1) : r * (q + 1) + (xcd - r) * q) + off; }
        const int nig = WGM * nN, gid = wgid / nig, fm = gid * WGM, gsz = (nM - fm) < WGM ? (nM - fm) : WGM;
        u.pm = fm + ((wgid % nig) % gsz); u.pn = (wgid % nig) / gsz; u.idx = i; return true;
    }
    __device__ __forceinline__ void a_ready(const Unit&) const {}
    __device__ __forceinline__ void done(const Unit&) const {}
};

typedef float f32x2c_t __attribute__((ext_vector_type(2))); typedef __bf16 bf16x2c_t __attribute__((ext_vector_type(2)));
__device__ __forceinline__ unsigned cvt_pk_bf16(float lo, float hi) { f32x2c_t v = {lo, hi}; bf16x2c_t b = __builtin_convertvector(v, bf16x2c_t); return __builtin_bit_cast(unsigned, b); }
typedef float f32x2 __attribute__((ext_vector_type(2)));
typedef unsigned u32x2 __attribute__((ext_vector_type(2)));
constexpr float RMS_EPS = 1e-6f;
__device__ __forceinline__ float row_rstd(const float* ssq, int row) {
    const f32x4* p = (const f32x4*)(ssq + (size_t)row * 16);
    const f32x4 a = p[0], b = p[1], c = p[2], d = p[3];
    const float s = (((a[0] + a[1]) + (a[2] + a[3])) + ((b[0] + b[1]) + (b[2] + b[3]))) + (((c[0] + c[1]) + (c[2] + c[3])) + ((d[0] + d[1]) + (d[2] + d[3])));
    return __builtin_amdgcn_rsqf(s * (1.0f / 1024.0f) + RMS_EPS);
}
__device__ __forceinline__ float bf2f(unsigned short v) { return __uint_as_float((unsigned)v << 16); }
__device__ __forceinline__ float bflo(unsigned w) { return __uint_as_float(w << 16); }
__device__ __forceinline__ float bfhi(unsigned w) { return __uint_as_float(w & 0xffff0000u); }

struct EpiQKV {
    static constexpr bool PERM = true, AFTER_DRAIN = false;
    const PG8_LAS float* rt;
    unsigned char* __restrict__ ws;
    const float* __restrict__ gains;
    float c2;
    __device__ __forceinline__ void operator()(const f32x4 (&acc)[2][2][4][2], const Unit& u, int wr, int wc, int fr, int fq) const {
        const int pn = u.pn;
        int kind, plane, ct;
        if (pn < 6) { kind = 0; plane = pn >> 1; ct = pn & 1; } else if (pn < 12) { kind = 1; plane = (pn - 6) >> 1; ct = (pn - 6) & 1; } else { kind = 2; plane = (pn - 12) / 3; ct = (pn - 12) % 3; }
        const int pitch = kind == 2 ? 768 : 512, H = kind == 2 ? 12 : 8;
        const size_t pofs = (plane == 0 ? (size_t)(146 + 32 * kind) : (size_t)(258 + 64 * kind + (plane == 2 ? (kind == 2 ? 48 : 32) : 0))) << 20;
        bf16_t* P = (bf16_t*)(ws + pofs);
        const int row0 = u.pm * BM + wr * 64 + fr;
        const int lg = (kind == 2 && plane > 0) ? 2 * ct : 0;
        const int b = (u.pm * BM) >> 11, t0 = ((u.pm * BM) & 2047) + wr * 64 + fr;
        if (plane < 2) {
            const int hh = 4 * ct + wc; const bool normed = kind != 1, rot = kind == 2;
            f32x4 gv[2][2];
            { const float* gp = gains + ((kind == 2 ? 2 : 0) + plane) * 64; const float gs = plane == 0 ? c2 : 1.0f;
#pragma unroll
              for (int bj = 0; bj < 2; ++bj)
#pragma unroll
                  for (int n = 0; n < 2; ++n) gv[bj][n] = normed ? *(const f32x4*)(gp + 32 * bj + 8 * fq + 4 * n) * gs : (f32x4){1.f, 1.f, 1.f, 1.f}; }
            const float* COS = (const float*)(ws + WS_COS); const float* SIN = (const float*)(ws + WS_SIN);
#pragma unroll
            for (int ai = 0; ai < 2; ++ai)
#pragma unroll
                for (int m = 0; m < 4; ++m) { const int row = row0 + ai * HALF + m * 16; const float r = rt[u.idx * 256 + ai * HALF + wr * 64 + m * 16 + fr];
                    f32x4 v[2][2];
#pragma unroll
                    for (int bj = 0; bj < 2; ++bj)
#pragma unroll
                        for (int n = 0; n < 2; ++n) v[bj][n] = acc[ai][bj][m][n] * r;
                    if (normed) { float ss = 0.f;
#pragma unroll
                        for (int bj = 0; bj < 2; ++bj)
#pragma unroll
                            for (int n = 0; n < 2; ++n) ss += (v[bj][n][0] * v[bj][n][0] + v[bj][n][1] * v[bj][n][1]) + (v[bj][n][2] * v[bj][n][2] + v[bj][n][3] * v[bj][n][3]);
                        ss += __shfl_xor(ss, 16); ss += __shfl_xor(ss, 32);
                        const float rn = __builtin_amdgcn_rsqf(ss * (1.0f / 64.0f) + RMS_EPS);
#pragma unroll
                        for (int bj = 0; bj < 2; ++bj)
#pragma unroll
                            for (int n = 0; n < 2; ++n) v[bj][n] = v[bj][n] * rn * gv[bj][n]; }
                    if (rot) {
#pragma unroll
                        for (int n = 0; n < 2; ++n) { const f32x4 cs = *(const f32x4*)(COS + (size_t)row * 32 + 8 * fq + 4 * n), sn = *(const f32x4*)(SIN + (size_t)row * 32 + 8 * fq + 4 * n);
                            const f32x4 x1 = v[0][n], x2 = v[1][n]; v[0][n] = x1 * cs - x2 * sn; v[1][n] = x2 * cs + x1 * sn; } }
                    bf16_t* dst;
                    if (plane == 0) dst = P + (size_t)row * pitch + hh * 64 + 8 * fq;
                    else { const int t = t0 + ai * HALF + m * 16; const int tpos = ((t & ((1 << lg) - 1)) << (11 - lg)) + (t >> lg); dst = P + ((size_t)(b * H + hh) * 2048 + tpos) * 64 + 8 * fq; }
#pragma unroll
                    for (int bj = 0; bj < 2; ++bj) { u32x4 w; w.x = cvt_pk_bf16(v[bj][0][0], v[bj][0][1]); w.y = cvt_pk_bf16(v[bj][0][2], v[bj][0][3]); w.z = cvt_pk_bf16(v[bj][1][0], v[bj][1][1]); w.w = cvt_pk_bf16(v[bj][1][2], v[bj][1][3]);
                        *(u32x4*)(dst + 32 * bj) = w; } }
        } else {
#pragma unroll
            for (int ai = 0; ai < 2; ++ai)
#pragma unroll
                for (int m = 0; m < 4; ++m) { const int t = t0 + ai * HALF + m * 16; const int tpos = ((t & ((1 << lg) - 1)) << (11 - lg)) + (t >> lg); const float r = rt[u.idx * 256 + ai * HALF + wr * 64 + m * 16 + fr];
#pragma unroll
                    for (int bj = 0; bj < 2; ++bj) { const int colb = ct * 256 + bj * HALF + wc * 32 + 8 * fq; const int hh = colb >> 6, d0 = colb & 63;
                        bf16_t* vp = P + (((size_t)(b * H + hh) * 64 + (tpos >> 5)) * 64 + d0) * 32 + (tpos & 31);
#pragma unroll
                        for (int n = 0; n < 2; ++n) { const f32x4 v = acc[ai][bj][m][n] * r; const unsigned w0 = cvt_pk_bf16(v[0], v[1]), w1 = cvt_pk_bf16(v[2], v[3]);
                            vp[(4 * n + 0) * 32] = (bf16_t)(w0 & 0xffffu); vp[(4 * n + 1) * 32] = (bf16_t)(w0 >> 16);
                            vp[(4 * n + 2) * 32] = (bf16_t)(w1 & 0xffffu); vp[(4 * n + 3) * 32] = (bf16_t)(w1 >> 16); } } }
        }
    }
};
template <int ACT> struct EpiAct {
    static constexpr bool PERM = true, AFTER_DRAIN = false;
    const PG8_LAS float* rt; bf16_t* __restrict__ O; int ldc;
    __device__ __forceinline__ float act(float x) const { if (ACT == 0) return __builtin_amdgcn_rcpf(1.0f + __builtin_amdgcn_exp2f(-1.4426950408889634f * x)); const float y = fmaxf(x, 0.f); return y * y; }
    __device__ __forceinline__ void operator()(const f32x4 (&acc)[2][2][4][2], const Unit& u, int wr, int wc, int fr, int fq) const {
        const int row0 = u.pm * BM + wr * 64 + fr, col0 = u.pn * BM + wc * 32 + 8 * fq;
#pragma unroll
        for (int ai = 0; ai < 2; ++ai)
#pragma unroll
            for (int m = 0; m < 4; ++m) { const int row = row0 + ai * HALF + m * 16; const float r = rt[u.idx * 256 + ai * HALF + wr * 64 + m * 16 + fr]; bf16_t* rowp = O + (size_t)row * ldc + col0;
#pragma unroll
                for (int bj = 0; bj < 2; ++bj) { const f32x4 v0 = acc[ai][bj][m][0] * r, v1 = acc[ai][bj][m][1] * r;
                    u32x4 w; w.x = cvt_pk_bf16(act(v0[0]), act(v0[1])); w.y = cvt_pk_bf16(act(v0[2]), act(v0[3])); w.z = cvt_pk_bf16(act(v1[0]), act(v1[1])); w.w = cvt_pk_bf16(act(v1[2]), act(v1[3]));
                    *(u32x4*)(rowp + bj * HALF) = w; } }
    }
};
struct EpiMerge {
    static constexpr bool PERM = true, AFTER_DRAIN = false;
    const bf16_t* __restrict__ G; bf16_t* __restrict__ O; int BR;
    __device__ __forceinline__ void operator()(const f32x4 (&acc)[2][2][4][2], const Unit& u, int wr, int wc, int fr, int fq) const {
        const int row0 = u.pm * BM + wr * 64 + fr, col0 = u.pn * BM + wc * 32 + 8 * fq;
#pragma unroll
        for (int ai = 0; ai < 2; ++ai) {
#pragma unroll
            for (int mp = 0; mp < 2; ++mp) {
                u32x4 g[2][2], p[2][2];
#pragma unroll
                for (int mm = 0; mm < 2; ++mm)
#pragma unroll
                    for (int bj = 0; bj < 2; ++bj) g[mm][bj] = *(const u32x4*)(G + (size_t)(row0 + ai * HALF + (2 * mp + mm) * 16) * 1024 + col0 + bj * HALF);
                if (BR > 0) {
#pragma unroll
                    for (int mm = 0; mm < 2; ++mm)
#pragma unroll
                        for (int bj = 0; bj < 2; ++bj) p[mm][bj] = *(const u32x4*)(O + (size_t)(row0 + ai * HALF + (2 * mp + mm) * 16) * 1024 + col0 + bj * HALF);
                } else {
#pragma unroll
                    for (int mm = 0; mm < 2; ++mm)
#pragma unroll
                        for (int bj = 0; bj < 2; ++bj) p[mm][bj] = (u32x4){0u, 0u, 0u, 0u};
                }
#pragma unroll
                for (int mm = 0; mm < 2; ++mm)
#pragma unroll
                    for (int bj = 0; bj < 2; ++bj) { const int m = 2 * mp + mm; const u32x4 gg = g[mm][bj], pp = p[mm][bj]; const f32x4 a0 = acc[ai][bj][m][0], a1 = acc[ai][bj][m][1];
                        const float o0 = a0[0] * bflo(gg.x) + bflo(pp.x), o1 = a0[1] * bfhi(gg.x) + bfhi(pp.x), o2 = a0[2] * bflo(gg.y) + bflo(pp.y), o3 = a0[3] * bfhi(gg.y) + bfhi(pp.y);
                        const float o4 = a1[0] * bflo(gg.z) + bflo(pp.z), o5 = a1[1] * bfhi(gg.z) + bfhi(pp.z), o6 = a1[2] * bflo(gg.w) + bflo(pp.w), o7 = a1[3] * bfhi(gg.w) + bfhi(pp.w);
                        u32x4 w; w.x = cvt_pk_bf16(o0, o1); w.y = cvt_pk_bf16(o2, o3); w.z = cvt_pk_bf16(o4, o5); w.w = cvt_pk_bf16(o6, o7);
                        *(u32x4*)(O + (size_t)(row0 + ai * HALF + m * 16) * 1024 + col0 + bj * HALF) = w; }
            }
        }
    }
};
struct EpiRes {
    static constexpr bool PERM = false, AFTER_DRAIN = false;
    const float* __restrict__ xin; float* __restrict__ xout; bf16_t* __restrict__ xn; const float* __restrict__ gain; float* __restrict__ ssq;
    __device__ __forceinline__ void operator()(const f32x4 (&acc)[2][2][4][2], const Unit& u, int wr, int wc, int fr, int fq) const {
        const int col0 = u.pn * BM + wc * 32 + 4 * fq; const bool nx = xn != nullptr;
        f32x4 gv[2][2];
#pragma unroll
        for (int bj = 0; bj < 2; ++bj)
#pragma unroll
            for (int n = 0; n < 2; ++n) gv[bj][n] = nx ? *(const f32x4*)(gain + col0 + bj * HALF + n * 16) : (f32x4){0.f, 0.f, 0.f, 0.f};
#pragma unroll
        for (int ai = 0; ai < 2; ++ai)
#pragma unroll
            for (int mp = 0; mp < 2; ++mp) {
                f32x4 xi[2][2][2];
#pragma unroll
                for (int mm = 0; mm < 2; ++mm) { const size_t off = (size_t)(u.pm * BM + ai * HALF + wr * 64 + (2 * mp + mm) * 16 + fr) * 1024 + col0;
#pragma unroll
                    for (int bj = 0; bj < 2; ++bj)
#pragma unroll
                        for (int n = 0; n < 2; ++n) xi[mm][bj][n] = *(const f32x4*)(xin + off + bj * HALF + n * 16); }
#pragma unroll
                for (int mm = 0; mm < 2; ++mm) { const int m = 2 * mp + mm; const int row = u.pm * BM + ai * HALF + wr * 64 + m * 16 + fr; const size_t off = (size_t)row * 1024 + col0; float s = 0.f;
#pragma unroll
                    for (int bj = 0; bj < 2; ++bj)
#pragma unroll
                        for (int n = 0; n < 2; ++n) { const f32x4 o = xi[mm][bj][n] + acc[ai][bj][m][n];
                            *(f32x4*)(xout + off + bj * HALF + n * 16) = o;
                            if (nx) { s += (o[0] * o[0] + o[1] * o[1]) + (o[2] * o[2] + o[3] * o[3]); const f32x4 y = o * gv[bj][n]; u32x2 w; w.x = cvt_pk_bf16(y[0], y[1]); w.y = cvt_pk_bf16(y[2], y[3]);
                                *(u32x2*)(xn + off + bj * HALF + n * 16) = w; } }
                    if (nx) { s += __shfl_xor(s, 16); s += __shfl_xor(s, 32); if (fq == 0) ssq[(size_t)row * 16 + u.pn * 4 + wc] = s; } }
            }
    }
};
template <class Epi, class Sched, bool ALIGN_EPI = false, bool SP2 = false>
__device__ __forceinline__ void gemm_phase(PG8_LAS unsigned char* lds, const Gemm g, const Sched& S, const Epi& E) {
    int tid_ = threadIdx.x; asm volatile("" : "+v"(tid_));
    const int tid = tid_, wid = __builtin_amdgcn_readfirstlane(tid >> 6), lane = tid & 63, wr = wid >> 2, wc = wid & 3, fr = lane & 15, fq = lane >> 4;
    const int K = g.K, nt = K / BK;
    unsigned voffA[2], voffB[2];
#pragma unroll
    for (int i = 0; i < 2; ++i) { int R, C; stage_rc(tid * 16 + i * 8192, R, C); const int Rb = Epi::PERM ? ((R & ~31) + perm32(R & 31)) : R;
        voffA[i] = (unsigned)(R * K + C) * 2u; voffB[i] = (unsigned)(Rb * K + C) * 2u; }
    const size_t kstep = (size_t)(BK * 2);
    const size_t hstep = (size_t)HALF * K * 2;
    const size_t tstep = 2 * hstep;
    const unsigned ldsw = (unsigned)wid * 1024u;
    const int aoff = lds_byte(wr * 64 + fr, fq * 8), boff = lds_byte(wc * 32 + fr, fq * 8);
#define PG8_SA(b, h) (((b) * 2 + (h)) * HTB)
#define PG8_SB(b, h) ((4 + (b) * 2 + (h)) * HTB)
#define PG8_STAGE(bufoff, gbase, voff) do { _Pragma("unroll") for (int _i = 0; _i < 2; ++_i) \
        __builtin_amdgcn_global_load_lds((const unsigned*)((const char*)(gbase) + (voff)[_i]), (PG8_LAS unsigned*)(lds + (bufoff) + ldsw + _i * 8192), 16, 0, 0); } while (0)
#define PG8_LDA(dst, b, h) do { _Pragma("unroll") for (int m = 0; m < 4; ++m) _Pragma("unroll") for (int k = 0; k < 2; ++k) dst[m][k] = *(const PG8_LAS bf16x8*)(lds + PG8_SA(b, h) + aoff + m * 2048 + k * 1024); } while (0)
#define PG8_LDB(dst, b, h) do { _Pragma("unroll") for (int n = 0; n < 2; ++n) _Pragma("unroll") for (int k = 0; k < 2; ++k) dst[n][k] = *(const PG8_LAS bf16x8*)(lds + PG8_SB(b, h) + boff + n * 2048 + k * 1024); } while (0)
#define PG8_MMA(ai, bj, At, Bt) do { __builtin_amdgcn_s_setprio(1); _Pragma("unroll") for (int m = 0; m < 4; ++m) _Pragma("unroll") for (int n = 0; n < 2; ++n) _Pragma("unroll") for (int k = 0; k < 2; ++k) \
        acc[ai][bj][m][n] = __builtin_amdgcn_mfma_f32_16x16x32_bf16(Bt[n][k], At[m][k], acc[ai][bj][m][n], 0, 0, 0); __builtin_amdgcn_s_setprio(0); } while (0)
#define PG8_WAIT_V(n) asm volatile("s_waitcnt vmcnt(" #n ")" ::: "memory")
#define PG8_WAIT_L(n) asm volatile("s_waitcnt lgkmcnt(" #n ")" ::: "memory")
#define PG8_BAR __builtin_amdgcn_s_barrier()
#define PG8_SCHED __builtin_amdgcn_sched_barrier(0)
    Unit cur, nxt; int ui = 0;
    if (!S.next(0, cur)) return;
    f32x4 acc[2][2][4][2];
#pragma unroll
    for (int a = 0; a < 2; ++a)
#pragma unroll
        for (int b = 0; b < 2; ++b)
#pragma unroll
            for (int m = 0; m < 4; ++m)
#pragma unroll
                for (int n = 0; n < 2; ++n) acc[a][b][m][n] = (f32x4){0.f, 0.f, 0.f, 0.f};
    bf16x8 At[4][2], B0[2][2], B1[2][2];
    const char* cA = (const char*)g.A + (size_t)cur.pm * tstep; const char* cB = (const char*)g.Bt + (size_t)cur.pn * tstep;
    S.a_ready(cur);
    if constexpr (SP2) {
        PG8_STAGE(PG8_SB(0, 0), cB, voffB); PG8_STAGE(PG8_SB(0, 1), cB + hstep, voffB); PG8_STAGE(PG8_SA(0, 0), cA, voffA); PG8_STAGE(PG8_SA(0, 1), cA + hstep, voffA);
        if (wr == 1) PG8_BAR;
        PG8_WAIT_V(2); PG8_BAR;
        PG8_STAGE(PG8_SB(1, 0), cB + kstep, voffB); PG8_STAGE(PG8_SA(1, 0), cA + kstep, voffA); PG8_STAGE(PG8_SB(1, 1), cB + hstep + kstep, voffB);
        PG8_WAIT_V(6); PG8_BAR;
    } else {
        PG8_STAGE(PG8_SB(0, 0), cB, voffB); PG8_STAGE(PG8_SA(0, 0), cA, voffA); PG8_STAGE(PG8_SB(0, 1), cB + hstep, voffB); PG8_STAGE(PG8_SA(0, 1), cA + hstep, voffA);
        if (wr == 1) PG8_BAR;
        PG8_WAIT_V(4); PG8_BAR;
        PG8_STAGE(PG8_SB(1, 0), cB + kstep, voffB); PG8_STAGE(PG8_SA(1, 0), cA + kstep, voffA); PG8_STAGE(PG8_SB(1, 1), cB + hstep + kstep, voffB);
        PG8_WAIT_V(6); PG8_BAR;
    }
    for (;;) {
        const bool has_next = S.next(ui + 1, nxt);
        const char* nA = has_next ? (const char*)g.A + (size_t)nxt.pm * tstep : cA; const char* nB = has_next ? (const char*)g.Bt + (size_t)nxt.pn * tstep : cB;
        for (int t = 0; t < nt; t += 2) {
            const bool last = (t == nt - 2);
            const char* a1 = cA + (size_t)(t + 1) * kstep;
            const char* a2 = last ? nA : cA + (size_t)(t + 2) * kstep; const char* b2 = last ? nB : cB + (size_t)(t + 2) * kstep;
            const char* a3 = a2 + kstep; const char* b3 = b2 + kstep;
            if (last && has_next) S.a_ready(nxt);
            if constexpr (SP2) {
            PG8_LDB(B0, 0, 0); PG8_LDB(B1, 0, 1); PG8_SCHED; PG8_LDA(At, 0, 0); PG8_STAGE(PG8_SA(1, 1), a1 + hstep, voffA);
            PG8_WAIT_V(8); PG8_WAIT_L(0); PG8_BAR; PG8_MMA(0, 0, At, B0); PG8_MMA(0, 1, At, B1); PG8_BAR; PG8_SCHED;
            PG8_LDA(At, 0, 1); PG8_STAGE(PG8_SB(0, 0), b2, voffB); PG8_STAGE(PG8_SB(0, 1), b2 + hstep, voffB); PG8_STAGE(PG8_SA(0, 0), a2, voffA);
            PG8_WAIT_V(8); PG8_WAIT_L(0); PG8_BAR; PG8_MMA(1, 0, At, B0); PG8_MMA(1, 1, At, B1); PG8_BAR; PG8_SCHED;
            PG8_LDB(B0, 1, 0); PG8_LDB(B1, 1, 1); PG8_SCHED; PG8_LDA(At, 1, 0); PG8_STAGE(PG8_SA(0, 1), a2 + hstep, voffA);
            PG8_WAIT_V(8); PG8_WAIT_L(0); PG8_BAR; PG8_MMA(0, 0, At, B0); PG8_MMA(0, 1, At, B1); PG8_BAR; PG8_SCHED;
            PG8_LDA(At, 1, 1); PG8_STAGE(PG8_SB(1, 0), b3, voffB); PG8_STAGE(PG8_SB(1, 1), b3 + hstep, voffB); PG8_STAGE(PG8_SA(1, 0), a3, voffA);
            PG8_WAIT_V(8); PG8_WAIT_L(0); PG8_BAR; PG8_MMA(1, 0, At, B0); PG8_MMA(1, 1, At, B1); PG8_BAR; PG8_SCHED;
            } else {
            PG8_LDB(B0, 0, 0); PG8_SCHED; PG8_LDA(At, 0, 0); PG8_STAGE(PG8_SA(1, 1), a1 + hstep, voffA);
            PG8_WAIT_L(8); PG8_BAR; PG8_WAIT_L(0); PG8_MMA(0, 0, At, B0); PG8_BAR; PG8_SCHED;
            PG8_LDB(B1, 0, 1); PG8_STAGE(PG8_SB(0, 0), b2, voffB);
            PG8_BAR; PG8_WAIT_L(0); PG8_MMA(0, 1, At, B1); PG8_BAR;
            PG8_LDA(At, 0, 1); PG8_STAGE(PG8_SA(0, 0), a2, voffA);
            PG8_BAR; PG8_WAIT_L(0); PG8_MMA(1, 0, At, B0); PG8_BAR; PG8_SCHED;
            PG8_STAGE(PG8_SB(0, 1), b2 + hstep, voffB);
            PG8_WAIT_V(6); PG8_BAR; PG8_MMA(1, 1, At, B1); PG8_BAR;
            PG8_LDB(B0, 1, 0); PG8_SCHED; PG8_LDA(At, 1, 0); PG8_STAGE(PG8_SA(0, 1), a2 + hstep, voffA);
            PG8_WAIT_L(8); PG8_BAR; PG8_WAIT_L(0); PG8_MMA(0, 0, At, B0); PG8_BAR; PG8_SCHED;
            PG8_LDB(B1, 1, 1); PG8_STAGE(PG8_SB(1, 0), b3, voffB);
            PG8_BAR; PG8_WAIT_L(0); PG8_MMA(0, 1, At, B1); PG8_BAR;
            PG8_LDA(At, 1, 1); PG8_STAGE(PG8_SA(1, 0), a3, voffA);
            PG8_BAR; PG8_WAIT_L(0); PG8_MMA(1, 0, At, B0); PG8_BAR; PG8_SCHED;
            PG8_STAGE(PG8_SB(1, 1), b3 + hstep, voffB);
            PG8_WAIT_V(6); PG8_BAR; PG8_MMA(1, 1, At, B1); PG8_BAR;
            }
        }
        if constexpr (ALIGN_EPI) { if (wr == 0) PG8_BAR; }
        if constexpr (!Epi::AFTER_DRAIN) { E(acc, cur, wr, wc, fr, fq); S.done(cur); }
        if (!has_next) break;
#pragma unroll
        for (int a = 0; a < 2; ++a)
#pragma unroll
            for (int b = 0; b < 2; ++b)
#pragma unroll
                for (int m = 0; m < 4; ++m)
#pragma unroll
                    for (int n = 0; n < 2; ++n) acc[a][b][m][n] = (f32x4){0.f, 0.f, 0.f, 0.f};
        cur = nxt; cA = nA; cB = nB; ++ui;
        if constexpr (ALIGN_EPI) { if (wr == 1) PG8_BAR; }
    }
    PG8_WAIT_V(0);
    if constexpr (!ALIGN_EPI) { if (wr == 0) PG8_BAR; }
    PG8_BAR;
    if constexpr (Epi::AFTER_DRAIN) { E.fused(acc, cur, wr, wc, fr, fq, lds, wid, lane); S.done(cur); }
#undef PG8_SA
#undef PG8_SB
#undef PG8_STAGE
#undef PG8_LDA
#undef PG8_LDB
#undef PG8_MMA
#undef PG8_WAIT_V
#undef PG8_WAIT_L
#undef PG8_BAR
#undef PG8_SCHED
}
}

#define GAS __attribute__((address_space(1)))
#define LAS __attribute__((address_space(3)))
typedef unsigned short bf16;
typedef unsigned v4u __attribute__((ext_vector_type(4)));
typedef unsigned v2u __attribute__((ext_vector_type(2)));
typedef float f32x4 __attribute__((ext_vector_type(4)));
typedef float f32x16 __attribute__((ext_vector_type(16)));
typedef short bf16x8 __attribute__((ext_vector_type(8)));
#define LDS_WAIT() asm volatile("s_waitcnt lgkmcnt(0)" ::: "memory")

struct Args { const void* in[16]; float* out; unsigned char* ws; int ph_lo, ph_hi; };

struct Frame {
    LAS unsigned char* lds; unsigned char* ws; int tid, lane, wave, G, gw, NGW;
};
#define IN_X(a)        ((const float*)(a).in[0])
#define IN_POS(a)      ((const int*)(a).in[1])
#define IN_ATTN_NORM(a) ((const float*)(a).in[2])
#define IN_W_IN(a)     ((const float*)(a).in[3])
#define IN_B_FORGET(a) ((const float*)(a).in[4])
#define IN_QNF(a)      ((const float*)(a).in[5])
#define IN_KNF(a)      ((const float*)(a).in[6])
#define IN_QND(a)      ((const float*)(a).in[7])
#define IN_KND(a)      ((const float*)(a).in[8])
#define IN_W_UP_FOX(a) ((const float*)(a).in[9])
#define IN_W_UP_SB(a)  ((const float*)(a).in[10])
#define IN_W_UP_DIL(a) ((const float*)(a).in[11])
#define IN_W_OUT(a)    ((const float*)(a).in[12])
#define IN_MLP_NORM(a) ((const float*)(a).in[13])
#define IN_W_MLP_IN(a) ((const float*)(a).in[14])
#define IN_W_MLP_OUT(a) ((const float*)(a).in[15])
__device__ __forceinline__ unsigned f2bf(float f) { unsigned u = __builtin_bit_cast(unsigned, f); return (u + 0x7fffu + ((u >> 16) & 1u)) >> 16; }
__device__ __forceinline__ unsigned pk2(float lo, float hi) { return f2bf(lo) | (f2bf(hi) << 16); }
__device__ __forceinline__ float blo(unsigned w) { return __uint_as_float(w << 16); }
__device__ __forceinline__ float bhi(unsigned w) { return __uint_as_float(w & 0xffff0000u); }
__device__ __forceinline__ float wave_sum(float v) {
#pragma unroll
    for (int o = 1; o < 64; o <<= 1) v += __shfl_xor(v, o);
    return v;
}

__device__ __forceinline__ void tr_item(const float* W, int pitch, int K, bf16* WT, int nblk, float scale, LAS float* scr, int item, int lane, bool perm = false) {
    const int kb = item / nblk, nb = item % nblk, k0 = 64 * kb, n0 = 32 * nb;
    const int s0 = perm ? (n0 & ~255) + ((n0 >> 5) & 3) * 64 + ((n0 >> 7) & 1) * 32 : n0;
#pragma unroll 8
    for (int i = 0; i < 32; ++i) { const int kk = 2 * i + (lane >> 5); scr[kk * 33 + (lane & 31)] = W[(size_t)(k0 + kk) * pitch + s0 + (lane & 31)]; }
    LDS_WAIT(); asm volatile("" ::: "memory");
    const int c = lane & 7;
#pragma unroll
    for (int j = 0; j < 4; ++j) { const int n = (lane >> 3) + 8 * j; const LAS float* s = scr + (8 * c) * 33 + n;
        v4u o; o.x = pk2(s[0 * 33] * scale, s[1 * 33] * scale); o.y = pk2(s[2 * 33] * scale, s[3 * 33] * scale); o.z = pk2(s[4 * 33] * scale, s[5 * 33] * scale); o.w = pk2(s[6 * 33] * scale, s[7 * 33] * scale);
        *(v4u*)(WT + (size_t)(n0 + n) * K + k0 + 8 * c) = o; }
    LDS_WAIT(); asm volatile("" ::: "memory");
}
__device__ __forceinline__ void p0_prologue(const Frame& F, const Args& A) {
    LAS float* scr = (LAS float*)(F.lds + F.wave * 16384);
    if (blockIdx.x == 0 && F.tid < DEPTH) ((unsigned*)(F.ws + WS_CTL))[F.tid * 64] = 0u;
    for (int it = F.gw; it < DEPTH * ITEMS_PER_LAYER; it += F.NGW) {
        const int layer = it / ITEMS_PER_LAYER; int r = it % ITEMS_PER_LAYER;
        unsigned char* wl = F.ws + WS_W + (size_t)layer * WL_STRIDE;
        const float* win = IN_W_IN(A) + (size_t)layer * DMODEL * DIN;
        bf16* wq = (bf16*)(wl + WL_QKV);
        if (r < 512) { tr_item(win, DIN, 1024, wq, 32, 1.f, scr, r, F.lane, true); continue; } r -= 512;
        if (r < 256) { tr_item(win + 1024, DIN, 1024, wq + (size_t)1024 * 1024, 16, 1.f, scr, r, F.lane); continue; } r -= 256;
        if (r < 256) { tr_item(win + 1544, DIN, 1024, wq + (size_t)1536 * 1024, 16, C2, scr, r, F.lane, true); continue; } r -= 256;
        if (r < 256) { tr_item(win + 2056, DIN, 1024, wq + (size_t)2048 * 1024, 16, 1.f, scr, r, F.lane, true); continue; } r -= 256;
        if (r < 256) { tr_item(win + 2568, DIN, 1024, wq + (size_t)2560 * 1024, 16, 1.f, scr, r, F.lane); continue; } r -= 256;
        if (r < 768) { tr_item(win + 3080, DIN, 1024, wq + (size_t)3072 * 1024, 48, 1.f, scr, r, F.lane, true); continue; } r -= 768;
        if (r < 384) { tr_item(win + 4616, DIN, 1024, wq + (size_t)4608 * 1024, 24, 1.f, scr, r, F.lane); continue; } r -= 384;
        if (r < 1536) { tr_item(win + 5384, DIN, 1024, (bf16*)(wl + WL_G), 96, 1.f, scr, r, F.lane); continue; } r -= 1536;
        if (r < 256) { tr_item(IN_W_UP_FOX(A) + (size_t)layer * 512 * 1024, 1024, 512, (bf16*)(wl + WL_A), 32, 1.f, scr, r, F.lane); continue; } r -= 256;
        if (r < 256) { tr_item(IN_W_UP_SB(A) + (size_t)layer * 512 * 1024, 1024, 512, (bf16*)(wl + WL_B), 32, 1.f, scr, r, F.lane); continue; } r -= 256;
        if (r < 128) { tr_item(IN_W_UP_DIL(A) + (size_t)layer * 256 * 1024, 1024, 256, (bf16*)(wl + WL_C), 32, 1.f, scr, r, F.lane); continue; } r -= 128;
        if (r < 512) { tr_item(IN_W_OUT(A) + (size_t)layer * 1024 * 1024, 1024, 1024, (bf16*)(wl + WL_O), 32, 1.f, scr, r, F.lane); continue; } r -= 512;
        if (r < 2048) { tr_item(IN_W_MLP_IN(A) + (size_t)layer * 1024 * 4096, 4096, 1024, (bf16*)(wl + WL_MI), 128, 1.f, scr, r, F.lane); continue; } r -= 2048;
        tr_item(IN_W_MLP_OUT(A) + (size_t)layer * 4096 * 1024, 1024, 4096, (bf16*)(wl + WL_MO), 32, 1.f, scr, r, F.lane);
    }
    bf16* XN = (bf16*)(F.ws + WS_R0); float* SSQ = (float*)(F.ws + WS_SSQ);
    for (int m = F.gw; m < M; m += F.NGW) {
        const f32x4* xr = (const f32x4*)(IN_X(A) + (size_t)m * DMODEL) + F.lane; const f32x4* gr = (const f32x4*)IN_ATTN_NORM(A) + F.lane;
        unsigned long long* o8 = (unsigned long long*)(XN + (size_t)m * DMODEL) + F.lane; float s = 0.f;
#pragma unroll
        for (int j = 0; j < 4; ++j) { const f32x4 v = xr[64 * j], g = gr[64 * j]; s += (v.x * v.x + v.y * v.y) + (v.z * v.z + v.w * v.w);
            o8[64 * j] = (unsigned long long)pk2(v.x * g.x, v.y * g.y) | ((unsigned long long)pk2(v.z * g.z, v.w * g.w) << 32); }
        s = wave_sum(s);
        if (F.lane < 16) SSQ[(size_t)m * 16 + F.lane] = F.lane == 0 ? s : 0.f;
    }
    if (F.gw == 0) { float* GN = (float*)(F.ws + WS_GAIN);
        for (int l = 0; l < DEPTH; ++l) { GN[l * 256 + F.lane] = IN_QNF(A)[l * 64 + F.lane]; GN[l * 256 + 64 + F.lane] = IN_KNF(A)[l * 64 + F.lane]; GN[l * 256 + 128 + F.lane] = IN_QND(A)[l * 64 + F.lane]; GN[l * 256 + 192 + F.lane] = IN_KND(A)[l * 64 + F.lane]; } }
    { float* COS = (float*)(F.ws + WS_COS); float* SIN = (float*)(F.ws + WS_SIN);
      for (int idx = F.gw * 64 + F.lane; idx < M * 32; idx += F.NGW * 64) { const int mrow = idx >> 5, i = idx & 31;
          const float a = (float)IN_POS(A)[mrow] * exp2f(-(float)i * (13.287712379549449f / 32.0f)); float sn, cs; sincosf(a, &sn, &cs); COS[idx] = cs; SIN[idx] = sn; } }
}

__device__ __forceinline__ void p1_forget(const Frame& F, const Args& A, int layer) {
    LAS bf16* wfb = (LAS bf16*)F.lds;
    LAS float* lfb = (LAS float*)(F.lds + 32768);
    const float* win = IN_W_IN(A) + (size_t)layer * DMODEL * DIN;
    if (blockIdx.x == 0 && F.tid < 3) ((unsigned*)(F.ws + WS_CTL))[F.tid == 0 ? layer * 64 : F.tid == 1 ? layer * 64 + 16 : 32] = 0u;
    for (int idx = F.tid; idx < 8192; idx += 512) { const int k = idx >> 3, j = idx & 7; wfb[j * 1056 + k] = (bf16)f2bf(win[(size_t)k * DIN + 1536 + j]); }
    __syncthreads();
    const int lane = F.lane;
    const float bfor = IN_B_FORGET(A)[layer * 8 + (lane & 7)];
    const bf16* XN = (const bf16*)(F.ws + WS_R0); const float* SSQ = (const float*)(F.ws + WS_SSQ);
    float* LFS = (float*)(F.ws + WS_LFS); float* CTOT = (float*)(F.ws + WS_CTOT);
    for (int chunk = blockIdx.x; chunk < M / 128; chunk += gridDim.x) {
        {
            typedef float f32x4m __attribute__((ext_vector_type(4)));
            const size_t row0 = (size_t)chunk * 128 + F.wave * 16; const int mr = lane & 15, kg = lane >> 4;
            const bf16* xa = XN + (row0 + mr) * DMODEL + 8 * kg; const LAS bf16* wb = wfb + (mr & 7) * 1056 + 8 * kg;
            f32x4m acc = {0.f, 0.f, 0.f, 0.f};
#pragma unroll 4
            for (int s = 0; s < 32; ++s) { const bf16x8 af = *(const bf16x8*)(xa + 32 * s); bf16x8 bfr = *(const LAS bf16x8*)(wb + 32 * s);
                if (mr >= 8) bfr = (bf16x8){0, 0, 0, 0, 0, 0, 0, 0};
                acc = __builtin_amdgcn_mfma_f32_16x16x32_bf16(af, bfr, acc, 0, 0, 0); }
            if (mr < 8) {
#pragma unroll
                for (int r = 0; r < 4; ++r) { const int rr = 4 * kg + r; const float y = acc[r] * pg8::row_rstd(SSQ, (int)(row0 + rr)) + bfor;
                    lfb[(F.wave * 16 + rr) * 8 + mr] = -(fmaxf(-y, 0.f) + log1pf(expf(-fabsf(y)))); } }
        }
        __syncthreads();
        if (F.wave == 0) {
            const int j = lane & 7, seg = lane >> 3; float run = 0.f;
#pragma unroll
            for (int i = 0; i < 16; ++i) { run += lfb[(seg * 16 + i) * 8 + j]; lfb[(seg * 16 + i) * 8 + j] = run; }
            float off = 0.f;
#pragma unroll
            for (int s = 1; s < 8; ++s) { const float o = __shfl_up(run, 8 * s); if (seg >= s) off += o; }
            const int b = chunk >> 4, t0 = (chunk & 15) * 128 + seg * 16;
#pragma unroll
            for (int i = 0; i < 16; ++i) LFS[((size_t)(b * 8 + j)) * 2048 + t0 + i] = lfb[(seg * 16 + i) * 8 + j] + off;
            if (seg == 7) CTOT[chunk * 8 + j] = off + run;
        }
        __syncthreads();
    }
}

typedef float f32x2_t __attribute__((ext_vector_type(2))); typedef __bf16 bf16x2_t __attribute__((ext_vector_type(2)));
__device__ __forceinline__ unsigned cvtpk(float lo, float hi) { f32x2_t v = {lo, hi}; bf16x2_t b = __builtin_convertvector(v, bf16x2_t); return __builtin_bit_cast(unsigned, b); }
template <int KIND> __device__ __forceinline__ void coop_block(const Frame& F, const float* gq_, const float* gk_, int b, int hh, int lg, int c, int QB) {
    const int tid = F.tid, lane = F.lane, w = F.wave, q = lane & 31, hi = lane >> 5;
    constexpr int H = KIND == 2 ? 12 : 8, pitch = KIND == 2 ? 768 : 512;
    bf16* Qp = (bf16*)(F.ws + (KIND == 0 ? WS_SBQ : KIND == 1 ? WS_FOXQ : WS_DILQ));
    const bf16* Kp = (const bf16*)(F.ws + (KIND == 0 ? WS_SBK : KIND == 1 ? WS_FOXK : WS_DILK));
    const bf16* Vt = (const bf16*)(F.ws + (KIND == 0 ? WS_SBV : KIND == 1 ? WS_FOXV : WS_DILV));
    const int Ls_ = 2048 >> lg, NTS = Ls_ >> 5;
    const int qt = 8 * QB + w; const bool wave_on = qt < NTS;
    const int base = 8 * QB, TMAX = (base + 7 < NTS - 1) ? base + 7 : NTS - 1;
    const int tq = c + ((32 * (wave_on ? qt : 0) + q) << lg);
    bf16* qrow = Qp + ((size_t)b * 2048 + tq) * pitch + hh * 64;
    bf16x8 qf[4];
#pragma unroll
    for (int d0 = 0; d0 < 4; ++d0) qf[d0] = *(const bf16x8*)(qrow + 16 * d0 + 8 * hi);
    const bool ldk = tid < 256; const int t2 = tid & 255;
    const int ki = t2 >> 3, kch = t2 & 7, kpi = (ki & 19) | ((ki & 4) << 1) | ((ki & 8) >> 1);
    const int vd = t2 >> 2, vc = t2 & 3;
    const bf16* gsrc = ldk ? Kp + ((size_t)(b * H + hh) * 2048 + c * Ls_ + kpi) * 64 + 8 * kch : Vt + ((size_t)(b * H + hh) * 64 + (c * Ls_ >> 5)) * 2048 + vd * 32 + 8 * vc;
    const int ldst = ldk ? ki * 128 + ((kch ^ ((ki >> 1) & 7)) << 4) : 49152 + vd * 64 + ((vc ^ ((vd >> 2) & 3)) << 4);
    int koff[4], voff[2][2];
#pragma unroll
    for (int d0 = 0; d0 < 4; ++d0) koff[d0] = q * 128 + (((2 * d0 + hi) ^ ((q >> 1) & 7)) << 4);
#pragma unroll
    for (int dh = 0; dh < 2; ++dh)
#pragma unroll
        for (int s2 = 0; s2 < 2; ++s2) { const int d = q + 32 * dh; voff[dh][s2] = 49152 + d * 64 + (((2 * s2 + hi) ^ ((d >> 2) & 3)) << 4); }
    float offs = 0.f; const float* lfrow = nullptr; f32x4 bs[4]; float Bq = 0.f;
    if (KIND == 1) {
        float gq = fabsf(gq_[lane]), gk = fabsf(gk_[lane]);
#pragma unroll
        for (int o = 1; o < 64; o <<= 1) { gq = fmaxf(gq, __shfl_xor(gq, o)); gk = fmaxf(gk, __shfl_xor(gk, o)); }
        Bq = 64.f * C2 * gq * gk * 1.02f + 0.01f; }
    if (KIND == 1) { const float ct = lane < 16 ? ((const float*)(F.ws + WS_CTOT))[(b * 16 + lane) * 8 + hh] : 0.f; float inc = ct;
#pragma unroll
        for (int o = 1; o < 16; o <<= 1) { const float t = __shfl_up(inc, o); if (lane >= o) inc += t; }
        offs = inc - ct;
        lfrow = (const float*)(F.ws + WS_LFS) + (size_t)(b * 8 + hh) * 2048 + 8 * hi;
#pragma unroll
        for (int g = 0; g < 4; ++g) bs[g] = *(const f32x4*)(lfrow + 32 * qt + 16 * (g >> 1) + 4 * (g & 1)); }
    f32x16 o0, o1;
#pragma unroll
    for (int r = 0; r < 16; ++r) { o0[r] = 0.f; o1[r] = 0.f; }
    float m = -1e30f, lsum = 0.f, carry = 0.f; bool done = !wave_on;
    LAS unsigned char* L = F.lds; LAS int* flg = (LAS int*)(L + 98304);
#define NEW_TILE(I) (KIND == 2 ? base + 3 + (I) : base - (I))
#define NEW_OK(I) (KIND == 2 ? ((I) <= 4 && NEW_TILE(I) <= TMAX) : (NEW_TILE(I) >= 0))
    { v4u r8[8]; const int f0 = KIND == 2 ? base - 4 : base;
#pragma unroll
      for (int k = 0; k < 8; ++k) { const int tl = f0 + k; if (tl >= 0 && tl <= TMAX) r8[k] = *(const v4u*)(gsrc + (size_t)2048 * tl); }
#pragma unroll
      for (int k = 0; k < 8; ++k) { const int tl = f0 + k; if (tl >= 0 && tl <= TMAX) *(LAS v4u*)(L + 4096 * (tl % 12) + ldst) = r8[k]; } }
    v4u rS = (v4u){0u, 0u, 0u, 0u};
    if (NEW_OK(1)) rS = *(const v4u*)(gsrc + (size_t)2048 * NEW_TILE(1));
    __syncthreads();
    const int NI = KIND == 2 ? 5 : base + 8;
    for (int j = 0; j < NI; ++j) {
        if (NEW_OK(j + 1)) *(LAS v4u*)(L + 4096 * (NEW_TILE(j + 1) % 12) + ldst) = rS;
        if (NEW_OK(j + 2)) rS = *(const v4u*)(gsrc + (size_t)2048 * NEW_TILE(j + 2));
        const int t = KIND == 2 ? qt - 4 + j : qt - j;
        if (KIND != 2 && t < 0) done = true;
        const bool act = wave_on && t >= 0 && (KIND == 2 || !done);
        if (act) {
            const LAS unsigned char* Ls = L + 4096 * (t % 12);
            f32x16 s;
            float bnd = 0.f;
            if (KIND == 1) { const float off = __builtin_bit_cast(float, __builtin_amdgcn_readlane(__builtin_bit_cast(int, offs), t >> 2));
                bnd = Bq - (__builtin_bit_cast(float, __builtin_amdgcn_readlane(__builtin_bit_cast(int, bs[0].x), 0)) + off) * LOG2E;
#pragma unroll
                for (int g = 0; g < 4; ++g) { const f32x4 f = bs[g];
                    s[4 * g] = -(f.x + off) * LOG2E; s[4 * g + 1] = -(f.y + off) * LOG2E; s[4 * g + 2] = -(f.z + off) * LOG2E; s[4 * g + 3] = -(f.w + off) * LOG2E; }
                if (t > 0) {
#pragma unroll
                    for (int g = 0; g < 4; ++g) bs[g] = *(const f32x4*)(lfrow + 32 * (t - 1) + 16 * (g >> 1) + 4 * (g & 1)); }
            } else {
#pragma unroll
                for (int r = 0; r < 16; ++r) s[r] = 0.f;
            }
            { bf16x8 kf[4];
#pragma unroll
              for (int d0 = 0; d0 < 4; ++d0) kf[d0] = *(const LAS bf16x8*)(Ls + koff[d0]);
              __builtin_amdgcn_s_setprio(1);
#pragma unroll
              for (int d0 = 0; d0 < 4; ++d0) s = __builtin_amdgcn_mfma_f32_32x32x16_bf16(kf[d0], qf[d0], s, 0, 0, 0);
              __builtin_amdgcn_s_setprio(0); }
            float p[16];
            if (KIND == 0) {
                float ln[16];
#pragma unroll
                for (int r = 0; r < 16; ++r) { const float z = s[r]; ln[r] = -(fmaxf(z, 0.f) + __builtin_amdgcn_logf(1.f + __builtin_amdgcn_exp2f(-fabsf(z)))); }
                if (t == qt) {
#pragma unroll
                    for (int r = 0; r < 16; ++r) if (16 * (r >> 3) + 8 * hi + (r & 7) >= q) ln[r] = 0.f;
                }
                float S0 = 0.f, S1 = 0.f;
#pragma unroll
                for (int e = 0; e < 8; ++e) { S0 += ln[e]; S1 += ln[8 + e]; }
                const float X0 = __shfl_xor(S0, 32), X1 = __shfl_xor(S1, 32);
                float run0 = carry + X1 + S1 + (hi == 0 ? X0 : 0.f), run1 = carry + (hi == 0 ? X1 : 0.f);
#pragma unroll
                for (int e = 7; e >= 0; --e) { run0 += ln[e]; p[e] = __builtin_amdgcn_exp2f(s[e] + run0); run1 += ln[8 + e]; p[8 + e] = __builtin_amdgcn_exp2f(s[8 + e] + run1); }
                if (t == qt) {
#pragma unroll
                    for (int r = 0; r < 16; ++r) if (16 * (r >> 3) + 8 * hi + (r & 7) >= q) p[r] = 0.f;
                }
                carry += (S0 + S1) + (X0 + X1);
                if (__all(carry < -160.f) || t == 0) done = true;
            } else {
                if (t == qt) {
#pragma unroll
                    for (int r = 0; r < 16; ++r) if (16 * (r >> 3) + 8 * hi + (r & 7) > q) s[r] = -1e30f;
                }
                if (KIND == 2 && t + 4 == qt) {
#pragma unroll
                    for (int r = 0; r < 16; ++r) if (16 * (r >> 3) + 8 * hi + (r & 7) < q) s[r] = -1e30f;
                }
                float tm = s[0];
#pragma unroll
                for (int r = 1; r < 16; ++r) tm = fmaxf(tm, s[r]);
                tm = fmaxf(tm, __shfl_xor(tm, 32));
                const float mn = fmaxf(m, tm), alpha = __builtin_amdgcn_exp2f(m - mn); m = mn;
                float ps = 0.f;
#pragma unroll
                for (int r = 0; r < 16; ++r) { p[r] = __builtin_amdgcn_exp2f(s[r] - mn); ps += p[r]; }
                lsum = lsum * alpha + ps;
#pragma unroll
                for (int r = 0; r < 16; ++r) { o0[r] *= alpha; o1[r] *= alpha; }
                if (KIND == 1 && (__all(bnd - m < -150.f) || t == 0)) done = true;
            }
            v4u w0, w1; w0.x = cvtpk(p[0], p[1]); w0.y = cvtpk(p[2], p[3]); w0.z = cvtpk(p[4], p[5]); w0.w = cvtpk(p[6], p[7]);
            w1.x = cvtpk(p[8], p[9]); w1.y = cvtpk(p[10], p[11]); w1.z = cvtpk(p[12], p[13]); w1.w = cvtpk(p[14], p[15]);
            const bf16x8 pb0 = __builtin_bit_cast(bf16x8, w0), pb1 = __builtin_bit_cast(bf16x8, w1);
            { const bf16x8 v00 = *(const LAS bf16x8*)(Ls + voff[0][0]), v01 = *(const LAS bf16x8*)(Ls + voff[0][1]), v10 = *(const LAS bf16x8*)(Ls + voff[1][0]), v11 = *(const LAS bf16x8*)(Ls + voff[1][1]);
              o0 = __builtin_amdgcn_mfma_f32_32x32x16_bf16(v00, pb0, o0, 0, 0, 0); o0 = __builtin_amdgcn_mfma_f32_32x32x16_bf16(v01, pb1, o0, 0, 0, 0);
              o1 = __builtin_amdgcn_mfma_f32_32x32x16_bf16(v10, pb0, o1, 0, 0, 0); o1 = __builtin_amdgcn_mfma_f32_32x32x16_bf16(v11, pb1, o1, 0, 0, 0); }
        }
        if (KIND != 2) { if (lane == 0) flg[(j & 1) * 8 + w] = done ? 0 : 1; }
        __syncthreads();
        if (KIND != 2) { const LAS int* fp = flg + (j & 1) * 8; const int any = fp[0] | fp[1] | fp[2] | fp[3] | fp[4] | fp[5] | fp[6] | fp[7]; if (any == 0) break; }
    }
#undef NEW_TILE
#undef NEW_OK
    if (wave_on) {
        float inv = 1.0f;
        if (KIND != 0) { lsum += __shfl_xor(lsum, 32); inv = 1.0f / lsum;
            if (KIND == 2 && hi == 0) ((float*)(F.ws + WS_LSE))[((size_t)b * 2048 + tq) * 12 + hh] = m + __builtin_amdgcn_logf(lsum); }
#pragma unroll
        for (int g = 0; g < 4; ++g) { v2u a; a.x = cvtpk(o0[4 * g] * inv, o0[4 * g + 1] * inv); a.y = cvtpk(o0[4 * g + 2] * inv, o0[4 * g + 3] * inv); *(v2u*)(qrow + 8 * g + 4 * hi) = a;
            v2u bq; bq.x = cvtpk(o1[4 * g] * inv, o1[4 * g + 1] * inv); bq.y = cvtpk(o1[4 * g + 2] * inv, o1[4 * g + 3] * inv); *(v2u*)(qrow + 32 + 8 * g + 4 * hi) = bq; }
    }
    __syncthreads();
}
constexpr int N_Q_UNITS = 1024 + 1024 + 512 + 512 + 1024;
__device__ __forceinline__ void p3_attention(const Frame& F, const Args& A, int layer) {
    const float* gq_ = IN_QNF(A) + layer * 64; const float* gk_ = IN_KNF(A) + layer * 64;
    unsigned* ctr = (unsigned*)(F.ws + WS_CTL) + layer * 64;
    LAS unsigned* uq = (LAS unsigned*)(F.lds + 98304 + 128);
    if (F.tid == 0) uq[0] = atomicAdd(ctr, 1u);
    __syncthreads();
    unsigned u = uq[0];
    for (;;) {
        if (u >= (unsigned)N_Q_UNITS) break;
        unsigned nxtu = 0u; if (F.tid == 0) nxtu = atomicAdd(ctr, 1u);
        if (u < 1024u) { const int QB = 7 - (int)(u >> 7), bh = u & 127; coop_block<1>(F, gq_, gk_, bh >> 3, bh & 7, 0, 0, QB); }
        else if (u < 2048u) { const int d = u - 1024; const int QB = 7 - (d >> 7), bh = d & 127; coop_block<0>(F, nullptr, nullptr, bh >> 3, bh & 7, 0, 0, QB); }
        else if (u < 2560u) { const int d = u - 2048; const int QB = 7 - (d >> 6), bj = d & 63; coop_block<2>(F, nullptr, nullptr, bj >> 2, bj & 3, 0, 0, QB); }
        else if (u < 3072u) { const int d = u - 2560; const int half = 1 - (d >> 8), r = d & 255; coop_block<2>(F, nullptr, nullptr, r >> 4, 4 + ((r >> 2) & 3), 2, r & 3, half); }
        else { const int d = u - 3072; coop_block<2>(F, nullptr, nullptr, d >> 6, 8 + ((d >> 4) & 3), 4, d & 15, 0); }
        if (F.tid == 0) uq[0] = nxtu;
        __syncthreads();
        u = uq[0];
    }
}
__device__ __forceinline__ void p4_combine(const Frame& F) {
    const float* LSE = (const float*)(F.ws + WS_LSE); const bf16* O = (const bf16*)(F.ws + WS_DILQ); bf16* OC = (bf16*)(F.ws + WS_OC);
    for (int pair = F.gw; pair < M / 2; pair += F.NGW) {
        const size_t tok = (size_t)2 * pair + (F.lane >> 5); const int sub = F.lane & 31, j = sub >> 3, d0 = (sub & 7) * 8;
        const float l0 = LSE[tok * 12 + j], l1 = LSE[tok * 12 + 4 + j], l2 = LSE[tok * 12 + 8 + j]; const float mx = fmaxf(l0, fmaxf(l1, l2));
        float w0 = __builtin_amdgcn_exp2f(l0 - mx), w1 = __builtin_amdgcn_exp2f(l1 - mx), w2 = __builtin_amdgcn_exp2f(l2 - mx); const float inv = 1.0f / (w0 + w1 + w2); w0 *= inv; w1 *= inv; w2 *= inv;
        const v4u a = *(const v4u*)(O + tok * 768 + j * 64 + d0), bq = *(const v4u*)(O + tok * 768 + (4 + j) * 64 + d0), cq = *(const v4u*)(O + tok * 768 + (8 + j) * 64 + d0);
        v4u o;
        o.x = pk2(w0 * blo(a.x) + w1 * blo(bq.x) + w2 * blo(cq.x), w0 * bhi(a.x) + w1 * bhi(bq.x) + w2 * bhi(cq.x));
        o.y = pk2(w0 * blo(a.y) + w1 * blo(bq.y) + w2 * blo(cq.y), w0 * bhi(a.y) + w1 * bhi(bq.y) + w2 * bhi(cq.y));
        o.z = pk2(w0 * blo(a.z) + w1 * blo(bq.z) + w2 * blo(cq.z), w0 * bhi(a.z) + w1 * bhi(bq.z) + w2 * bhi(cq.z));
        o.w = pk2(w0 * blo(a.w) + w1 * blo(bq.w) + w2 * blo(cq.w), w0 * bhi(a.w) + w1 * bhi(bq.w) + w2 * bhi(cq.w));
        *(v4u*)(OC + tok * 256 + j * 64 + d0) = o;
    }
}


__device__ const int PROG[] = {0, 1, 3, 4, 5, 6, 7, 8, 9, 11, 12, 13, 14, 15, 16};
constexpr int NPROG = sizeof(PROG) / sizeof(int);
typedef GAS unsigned gu32;
#define XB_TMO      128
#define XB_XCNT(j)  (256  + 64 * (j))
#define XB_XSUB(j)  (1280 + 64 * (j))
#define XB_XGEN(j)  (2304 + 64 * (j))
#define XB_TOP      3328
#define XB_TOPGEN   3392
#define XCD_BAR_WORDS 3456
#define XB_SPIN_CAP (1u << 18)

__device__ __forceinline__ unsigned xb_ld(unsigned* p)              { return __hip_atomic_load(p, __ATOMIC_RELAXED, __HIP_MEMORY_SCOPE_AGENT); }
__device__ __forceinline__ unsigned xb_add(unsigned* p, unsigned v) { return __hip_atomic_fetch_add(p, v, __ATOMIC_RELAXED, __HIP_MEMORY_SCOPE_AGENT); }
__device__ __forceinline__ unsigned xb_xcc_id() { return (unsigned)__builtin_amdgcn_s_getreg((3 << 11) | 20) & 0xFu; }
#define XB_SPIN(cond, bar) do { unsigned _sp = 0; while (cond) { __builtin_amdgcn_s_sleep(1); \
    if ((++_sp & 255u) == 0u) { if (xb_ld(&(bar)[XB_TMO])) break; if (_sp > XB_SPIN_CAP) { atomicAdd(&(bar)[XB_TMO], 1u); break; } } } } while (0)

struct XcdBarrier {
    unsigned* bar; unsigned x;
    volatile LAS unsigned* st;
};

__device__ __forceinline__ XcdBarrier xcd_barrier_post(unsigned* bar, volatile LAS unsigned* st) {
    XcdBarrier b; b.bar = bar; b.x = xb_xcc_id(); b.st = st;
    if (threadIdx.x == 0) (void)xb_add(&bar[XB_XCNT(b.x)], 1u);
    return b;
}
__device__ __forceinline__ void xcd_barrier_complete(unsigned* bar, unsigned x, unsigned& nloc, unsigned& nx) {
    const unsigned G = gridDim.x * gridDim.y * gridDim.z;
    unsigned sum, cnt, mine, sp = 0u;
    for (;;) {
        sum = 0u; cnt = 0u; mine = 0u;
#pragma unroll
        for (unsigned j = 0; j < 16; ++j) { const unsigned c = xb_ld(&bar[XB_XCNT(j)]); sum += c; cnt += (c > 0u) ? 1u : 0u; mine = (j == x) ? c : mine; }
        if (sum == G) break;
        __builtin_amdgcn_s_sleep(1);
        if ((++sp & 255u) == 0u) { if (xb_ld(&bar[XB_TMO])) break; if (sp > XB_SPIN_CAP) { atomicAdd(&bar[XB_TMO], 1u); break; } }
    }
    nloc = mine > 0u ? mine : 1u; nx = cnt > 0u ? cnt : 1u;
}

__device__ __forceinline__ void xcd_barrier(const XcdBarrier& b, bool leader  ) {
    asm volatile("s_waitcnt vmcnt(0)" ::: "memory");
    __syncthreads();
    if (leader) {
        unsigned* bar = b.bar;
        __builtin_amdgcn_s_waitcnt(0);
        unsigned nloc = b.st[0], nx = b.st[1];
        if (nloc == 0u) { xcd_barrier_complete(bar, b.x, nloc, nx); b.st[0] = nloc; b.st[1] = nx; }
        const unsigned old = xb_add(&bar[XB_XSUB(b.x)], 1u);
        const unsigned gen = old / nloc;
        if (old + 1u == (gen + 1u) * nloc) {
            __builtin_amdgcn_fence(__ATOMIC_RELEASE, "agent");
            asm volatile("s_waitcnt vmcnt(0)" ::: "memory");
            const unsigned og = xb_add(&bar[XB_TOP], 1u);
            const unsigned tg = og / nx;
            if (og + 1u == (tg + 1u) * nx) xb_add(&bar[XB_TOPGEN], 1u);
            else XB_SPIN(xb_ld(&bar[XB_TOPGEN]) == tg, bar);
            __builtin_amdgcn_fence(__ATOMIC_ACQUIRE, "agent");
            xb_add(&bar[XB_XGEN(b.x)], 1u);
            asm volatile("s_waitcnt vmcnt(0)" ::: "memory");
        } else {
            XB_SPIN(xb_ld(&bar[XB_XGEN(b.x)]) == gen, bar);
            __builtin_amdgcn_fence(__ATOMIC_ACQUIRE, "agent");
            asm volatile("s_waitcnt vmcnt(0)" ::: "memory");
        }
    }
    __syncthreads();
}

constexpr int RT_OFF = 131072, RT_MAX_UNITS = 15;
__device__ __forceinline__ void fill_rstd(const Frame& F, const pg8::StaticOrder& S, const float* SSQ) {
    LAS float* rt = (LAS float*)(F.lds + RT_OFF); pg8::Unit u;
    for (int i = 0; i < RT_MAX_UNITS && S.next(i, u); ++i) { const int rl = F.tid >> 1, hf = F.tid & 1;
        const f32x4* p = (const f32x4*)(SSQ + (size_t)(u.pm * 256 + rl) * 16 + 8 * hf); const f32x4 a = p[0], b = p[1];
        float s = ((a[0] + a[1]) + (a[2] + a[3])) + ((b[0] + b[1]) + (b[2] + b[3])); s += __shfl_xor(s, 1);
        if (hf == 0) rt[i * 256 + rl] = __builtin_amdgcn_rsqf(s * (1.0f / 1024.0f) + EPS); }
    __syncthreads();
}
__global__ void __launch_bounds__(NWAVES * 64, 2) fwd_mega(Args args) {
    extern __shared__ __attribute__((aligned(16))) unsigned char lds[];
    cg::grid_group grid = cg::this_grid();
    const Args& A = args;
    volatile LAS unsigned* xb_st = (volatile LAS unsigned*)((LAS unsigned char*)lds + LDS_BYTES - 64);
    if (threadIdx.x < 2) xb_st[threadIdx.x] = 0u;
    __syncthreads();
    const XcdBarrier xbar = xcd_barrier_post((unsigned*)(args.ws + WS_CTL + 65536), xb_st);
    for (int pi = args.ph_lo; pi < args.ph_hi; ++pi) {
        const int ph = PROG[pi];
        unsigned char* ws = args.ws; asm volatile("" : "+s"(ws));
        const float* SSQ = (const float*)(ws + WS_SSQ);
        int tid_ = threadIdx.x; asm volatile("" : "+v"(tid_));
        Frame F;
        F.lds = (LAS unsigned char*)lds; F.ws = ws;
        F.tid = tid_; F.lane = F.tid & 63; F.wave = __builtin_amdgcn_readfirstlane(F.tid >> 6);
        F.G = gridDim.x; F.gw = blockIdx.x * NWAVES + F.wave; F.NGW = F.G * NWAVES;
        if (ph == 0) { p0_prologue(F, A); }
        else {
            const int layer = (ph - 1) >> 3, sub = (ph - 1) & 7;
            unsigned char* wl = ws + WS_W + (size_t)layer * WL_STRIDE;
            const int bx = (int)blockIdx.x;
            if (sub == 0) {
                pg8::Gemm g{(const bf16*)(ws + WS_R0), (const bf16*)(wl + WL_QKV), M, NQKV, 1024}; pg8::StaticOrder S; S.init(M, NQKV, F.G, bx);
                p1_forget(F, A, layer);
                fill_rstd(F, S, SSQ);
                pg8::EpiQKV E{(const LAS float*)(F.lds + RT_OFF), ws, (const float*)(ws + WS_GAIN) + layer * 256, C2};
                pg8::gemm_phase<pg8::EpiQKV, pg8::StaticOrder, true, true>(F.lds, g, S, E);
            } else if (sub == 1) {
            } else if (sub == 2) { p3_attention(F, A, layer);
            } else if (sub == 3) {
                p4_combine(F);
            } else if (sub == 4) {
                pg8::StaticOrder S; S.init(M, 1024, F.G, bx);
                fill_rstd(F, S, SSQ);
#pragma unroll 1
                for (int br = 0; br < 3; ++br) {
                    { pg8::Gemm g{(const bf16*)(ws + WS_R0), (const bf16*)(wl + WL_G) + (size_t)br * 1024 * 1024, M, 1024, 1024};
                      pg8::EpiAct<0> E{(const LAS float*)(F.lds + RT_OFF), (bf16*)(ws + WS_GATE), 1024};
                      pg8::gemm_phase<pg8::EpiAct<0>, pg8::StaticOrder, true, true>(F.lds, g, S, E); }
                    { const bf16* Ab = (const bf16*)(ws + (br == 0 ? WS_FOXQ : br == 1 ? WS_SBQ : WS_OC)); const bf16* Bb = (const bf16*)(wl + (br == 0 ? WL_A : br == 1 ? WL_B : WL_C));
                      pg8::Gemm g{Ab, Bb, M, 1024, br == 2 ? 256 : 512}; pg8::EpiMerge E{(const bf16*)(ws + WS_GATE), (bf16*)(ws + WS_MRG), br};
                      pg8::gemm_phase<pg8::EpiMerge, pg8::StaticOrder, true, true>(F.lds, g, S, E); }
                }
            } else if (sub == 5) {
                pg8::Gemm g{(const bf16*)(ws + WS_MRG), (const bf16*)(wl + WL_O), M, 1024, 1024}; pg8::StaticOrder S; S.init(M, 1024, F.G, bx);
                pg8::EpiRes E{layer == 0 ? IN_X(A) : A.out, A.out, (bf16*)(ws + WS_R1), IN_MLP_NORM(A) + layer * 1024, (float*)(ws + WS_SSQ)};
                pg8::gemm_phase<pg8::EpiRes, pg8::StaticOrder, true, true>(F.lds, g, S, E);
            } else if (sub == 6) {
                pg8::Gemm g{(const bf16*)(ws + WS_R1), (const bf16*)(wl + WL_MI), M, DFF, 1024}; pg8::StaticOrder S; S.init(M, DFF, F.G, bx);
                fill_rstd(F, S, SSQ);
                pg8::EpiAct<1> E{(const LAS float*)(F.lds + RT_OFF), (bf16*)(ws + WS_HID), DFF};
                pg8::gemm_phase<pg8::EpiAct<1>, pg8::StaticOrder, true, true>(F.lds, g, S, E);
            } else {
                pg8::Gemm g{(const bf16*)(ws + WS_HID), (const bf16*)(wl + WL_MO), M, 1024, DFF}; pg8::StaticOrder S; S.init(M, 1024, F.G, bx);
                const bool last = layer == DEPTH - 1;
                pg8::EpiRes E{A.out, A.out, last ? (bf16*)nullptr : (bf16*)(ws + WS_R0), IN_ATTN_NORM(A) + (last ? 0 : (layer + 1) * 1024), (float*)(ws + WS_SSQ)};
                pg8::gemm_phase<pg8::EpiRes, pg8::StaticOrder, true, true>(F.lds, g, S, E);
            }
        }
        if (pi + 1 < args.ph_hi) {
            if (args.ph_hi > 4096) {
                asm volatile("s_waitcnt vmcnt(0) lgkmcnt(0)" ::: "memory");
                grid.sync();
                __builtin_amdgcn_fence(__ATOMIC_ACQUIRE, "agent");
                asm volatile("s_waitcnt vmcnt(0)" ::: "memory");
            } else xcd_barrier(xbar, F.tid == 0);
        }
    }
}


#ifndef N_LAUNCH_MODE
#define N_LAUNCH_MODE 1
#endif
extern "C" void kernel_launch(void* const* d_in, const int* in_sizes, int n_in, void* d_out, int out_size, void* d_ws, size_t ws_size, hipStream_t stream) {
    static int grid = 0;
    if (grid == 0) {
        if (n_in != 16 || out_size != M * DMODEL || ws_size < WS_END) { fprintf(stderr, "kernel_launch: unexpected shapes (n_in %d out %d ws %zu)\n", n_in, out_size, ws_size); grid = -1; return; }
        int dev = 0, cus = 0, per_cu = 0;
        hipGetDevice(&dev); hipDeviceGetAttribute(&cus, hipDeviceAttributeMultiprocessorCount, dev);
        hipFuncSetAttribute((const void*)fwd_mega, hipFuncAttributeMaxDynamicSharedMemorySize, LDS_BYTES);
        hipOccupancyMaxActiveBlocksPerMultiprocessor(&per_cu, (const void*)fwd_mega, NWAVES * 64, LDS_BYTES);
        if (per_cu < 1) per_cu = 1;
        grid = cus * per_cu;
        (void)hipGetLastError();
    }
    if (grid < 0) return;
    if (hipMemsetAsync((unsigned char*)d_ws + WS_CTL, 0, 131072, stream) != hipSuccess) { fprintf(stderr, "kernel_launch: memset of the control words failed\n"); return; }
    Args a{};
    for (int i = 0; i < 16; ++i) a.in[i] = d_in[i];
    a.out = (float*)d_out; a.ws = (unsigned char*)d_ws;
#if N_LAUNCH_MODE == 1
    a.ph_lo = 0; a.ph_hi = NPROG;
    { void* kargs[] = {&a}; hipError_t e = hipLaunchCooperativeKernel((const void*)fwd_mega, dim3(grid), dim3(NWAVES * 64), kargs, LDS_BYTES, stream);
      if (e != hipSuccess) fprintf(stderr, "cooperative launch failed: %s (grid %d)\n", hipGetErrorString(e), grid); }
#else
    const int nph = NPROG;
    for (int ph = 0; ph < nph; ++ph) { a.ph_lo = ph; a.ph_hi = ph + 1; void* kargs[] = {&a};
        hipError_t e = hipLaunchCooperativeKernel((const void*)fwd_mega, dim3(grid), dim3(NWAVES * 64), kargs, LDS_BYTES, stream);
        if (e != hipSuccess) { fprintf(stderr, "launch %d failed: %s\n", ph, hipGetErrorString(e)); break; } }
#endif
}
```

```cpp
#include <hip/hip_runtime.h>
#include <hip/hip_cooperative_groups.h>
#include <cstdio>
#include <cstdint>
#include <cmath>
namespace cg = cooperative_groups;
constexpr int NWAVES = 8;
constexpr int BATCH = 16, SEQ = 2048, DMODEL = 1024, DEPTH = 2, M = BATCH * SEQ, DIN = 8456, DFF = 4096;
constexpr int NQKV = 5376, NGATE = 3072;
constexpr float EPS = 1e-6f, LOG2E = 1.4426950408889634f, C2 = 0.125f * 1.4426950408889634f;
constexpr size_t KiB = 1024, MiB = 1u << 20;
constexpr size_t WL_QKV = 0, WL_G = 10752 * KiB, WL_A = 16896 * KiB, WL_B = 17920 * KiB, WL_C = 18944 * KiB, WL_O = 19456 * KiB, WL_MI = 21504 * KiB, WL_MO = 29696 * KiB, WL_STRIDE = 38 * MiB;
constexpr size_t WS_W = 0, WS_CTL = 76 * MiB, WS_SSQ = 77 * MiB, WS_LFS = 79 * MiB, WS_LSE = 80 * MiB, WS_CTOT = 81 * MiB + 512 * KiB;
constexpr size_t WS_R0 = 82 * MiB, WS_FOXQ = 146 * MiB, WS_SBQ = 178 * MiB, WS_DILQ = 210 * MiB;
constexpr size_t WS_FOXK = 258 * MiB, WS_FOXV = 290 * MiB, WS_SBK = 322 * MiB, WS_SBV = 354 * MiB, WS_DILK = 386 * MiB, WS_DILV = 434 * MiB;
constexpr size_t WS_GAIN = 81 * MiB + 768 * KiB;
constexpr size_t WS_COS = 498 * MiB, WS_SIN = 502 * MiB;
constexpr size_t WS_GATE = 258 * MiB  , WS_MRG = 322 * MiB  , WS_OC = 482 * MiB, WS_R1 = 146 * MiB, WS_HID = 210 * MiB, WS_END = 506 * MiB;
constexpr int LDS_BYTES = 147456;
constexpr int NPHASE = 1 + 8 * DEPTH;
constexpr int ITEMS_PER_LAYER = 9472;
constexpr int N_ATT_UNITS = 64 * 256 + 16 * 12 * 64;

static_assert(WS_FOXQ == 146 * MiB && WS_SBQ == 178 * MiB && WS_DILQ == 210 * MiB && WS_FOXK == 258 * MiB && WS_SBK == 322 * MiB && WS_DILK == 386 * MiB && WS_FOXV == 290 * MiB && WS_SBV == 354 * MiB && WS_DILV == 434 * MiB, "EpiQKV plane offsets");
static_assert(WS_FOXQ == 146 * MiB && WS_SBQ == 178 * MiB && WS_DILQ == 210 * MiB && WS_FOXK == 258 * MiB && WS_SBK == 322 * MiB && WS_DILK == 386 * MiB && WS_FOXV == 290 * MiB && WS_SBV == 354 * MiB && WS_DILV == 434 * MiB, "EpiQKV plane offsets");
namespace pg8 {
#define PG8_LAS __attribute__((address_space(3)))
typedef unsigned short bf16_t;
typedef short bf16x8 __attribute__((ext_vector_type(8)));
typedef float f32x4 __attribute__((ext_vector_type(4)));
typedef unsigned u32x4 __attribute__((ext_vector_type(4)));
constexpr int BM = 256, BK = 64, HALF = 128, HTB = HALF * BK * 2  , STAGE_BYTES = 8 * HTB, NXCD = 8, WGM = 8;

__host__ __device__ __forceinline__ int lds_byte(int r, int c) { const int st = (r >> 4) * 2 + (c >> 5), rr = r & 15, cc = c & 31, ob = rr * 64 + cc * 2; return st * 1024 + (ob ^ (((ob >> 9) & 1) << 5)); }
__host__ __device__ __forceinline__ void stage_rc(int b, int& R, int& C) { const int st = b / 1024, sb = b % 1024, swz = sb ^ (((sb >> 9) & 1) << 5); R = (st >> 1) * 16 + swz / 64; C = (st & 1) * 32 + (swz % 64) / 2; }
__host__ __device__ __forceinline__ int perm32(int rho) { const int n = rho >> 4, i = rho & 15; return 8 * (i >> 2) + 4 * n + (i & 3); }

struct Unit { int pm, pn, idx; };
struct Gemm { const bf16_t* A; const bf16_t* Bt; int M, N, K; };

struct StaticOrder {
    int nM, nN, nwg, G, c;
    __host__ __device__ void init(int M, int N, int G_, int c_) { nM = M / BM; nN = N / BM; nwg = nM * nN; G = G_; c = c_; }
    __host__ __device__ bool next(int i, Unit& u) const {
        const long L = (long)i * G + c; if (L >= nwg) return false;
        int wgid = (int)L; { const int q = nwg / NXCD, r = nwg % NXCD, xcd = wgid % NXCD, off = wgid / NXCD; wgid = (xcd < r ? xcd * (q + 1) : r * (q + 1) + (xcd - r) * q) + off; }
        const int nig = WGM * nN, gid = wgid / nig, fm = gid * WGM, gsz = (nM - fm) < WGM ? (nM - fm) : WGM;
        u.pm = fm + ((wgid % nig) % gsz); u.pn = (wgid % nig) / gsz; u.idx = i; return true;
    }
    __device__ __forceinline__ void a_ready(const Unit&) const {}
    __device__ __forceinline__ void done(const Unit&) const {}
};

typedef float f32x2c_t __attribute__((ext_vector_type(2))); typedef __bf16 bf16x2c_t __attribute__((ext_vector_type(2)));
__device__ __forceinline__ unsigned cvt_pk_bf16(float lo, float hi) { f32x2c_t v = {lo, hi}; bf16x2c_t b = __builtin_convertvector(v, bf16x2c_t); return __builtin_bit_cast(unsigned, b); }
typedef float f32x2 __attribute__((ext_vector_type(2)));
typedef unsigned u32x2 __attribute__((ext_vector_type(2)));
constexpr float RMS_EPS = 1e-6f;
__device__ __forceinline__ float row_rstd(const float* ssq, int row) {
    const f32x4* p = (const f32x4*)(ssq + (size_t)row * 16);
    const f32x4 a = p[0], b = p[1], c = p[2], d = p[3];
    const float s = (((a[0] + a[1]) + (a[2] + a[3])) + ((b[0] + b[1]) + (b[2] + b[3]))) + (((c[0] + c[1]) + (c[2] + c[3])) + ((d[0] + d[1]) + (d[2] + d[3])));
    return __builtin_amdgcn_rsqf(s * (1.0f / 1024.0f) + RMS_EPS);
}
__device__ __forceinline__ float bf2f(unsigned short v) { return __uint_as_float((unsigned)v << 16); }
__device__ __forceinline__ float bflo(unsigned w) { return __uint_as_float(w << 16); }
__device__ __forceinline__ float bfhi(unsigned w) { return __uint_as_float(w & 0xffff0000u); }

struct EpiQKV {
    static constexpr bool PERM = true, AFTER_DRAIN = false;
    const PG8_LAS float* rt;
    unsigned char* __restrict__ ws;
    const float* __restrict__ gains;
    float c2;
    __device__ __forceinline__ void operator()(const f32x4 (&acc)[2][2][4][2], const Unit& u, int wr, int wc, int fr, int fq) const {
        const int pn = u.pn;
        int kind, plane, ct;
        if (pn < 6) { kind = 0; plane = pn >> 1; ct = pn & 1; } else if (pn < 12) { kind = 1; plane = (pn - 6) >> 1; ct = (pn - 6) & 1; } else { kind = 2; plane = (pn - 12) / 3; ct = (pn - 12) % 3; }
        const int pitch = kind == 2 ? 768 : 512, H = kind == 2 ? 12 : 8;
        const size_t pofs = (plane == 0 ? (size_t)(146 + 32 * kind) : (size_t)(258 + 64 * kind + (plane == 2 ? (kind == 2 ? 48 : 32) : 0))) << 20;
        bf16_t* P = (bf16_t*)(ws + pofs);
        const int row0 = u.pm * BM + wr * 64 + fr;
        const int lg = (kind == 2 && plane > 0) ? 2 * ct : 0;
        const int b = (u.pm * BM) >> 11, t0 = ((u.pm * BM) & 2047) + wr * 64 + fr;
        if (plane < 2) {
            const int hh = 4 * ct + wc; const bool normed = kind != 1, rot = kind == 2;
            f32x4 gv[2][2];
            { const float* gp = gains + ((kind == 2 ? 2 : 0) + plane) * 64; const float gs = plane == 0 ? c2 : 1.0f;
#pragma unroll
              for (int bj = 0; bj < 2; ++bj)
#pragma unroll
                  for (int n = 0; n < 2; ++n) gv[bj][n] = normed ? *(const f32x4*)(gp + 32 * bj + 8 * fq + 4 * n) * gs : (f32x4){1.f, 1.f, 1.f, 1.f}; }
            const float* COS = (const float*)(ws + WS_COS); const float* SIN = (const float*)(ws + WS_SIN);
#pragma unroll
            for (int ai = 0; ai < 2; ++ai)
#pragma unroll
                for (int m = 0; m < 4; ++m) { const int row = row0 + ai * HALF + m * 16; const float r = rt[u.idx * 256 + ai * HALF + wr * 64 + m * 16 + fr];
                    f32x4 v[2][2];
#pragma unroll
                    for (int bj = 0; bj < 2; ++bj)
#pragma unroll
                        for (int n = 0; n < 2; ++n) v[bj][n] = acc[ai][bj][m][n] * r;
                    if (normed) { float ss = 0.f;
#pragma unroll
                        for (int bj = 0; bj < 2; ++bj)
#pragma unroll
                            for (int n = 0; n < 2; ++n) ss += (v[bj][n][0] * v[bj][n][0] + v[bj][n][1] * v[bj][n][1]) + (v[bj][n][2] * v[bj][n][2] + v[bj][n][3] * v[bj][n][3]);
                        ss += __shfl_xor(ss, 16); ss += __shfl_xor(ss, 32);
                        const float rn = __builtin_amdgcn_rsqf(ss * (1.0f / 64.0f) + RMS_EPS);
#pragma unroll
                        for (int bj = 0; bj < 2; ++bj)
#pragma unroll
                            for (int n = 0; n < 2; ++n) v[bj][n] = v[bj][n] * rn * gv[bj][n]; }
                    if (rot) {
#pragma unroll
                        for (int n = 0; n < 2; ++n) { const f32x4 cs = *(const f32x4*)(COS + (size_t)row * 32 + 8 * fq + 4 * n), sn = *(const f32x4*)(SIN + (size_t)row * 32 + 8 * fq + 4 * n);
                            const f32x4 x1 = v[0][n], x2 = v[1][n]; v[0][n] = x1 * cs - x2 * sn; v[1][n] = x2 * cs + x1 * sn; } }
                    bf16_t* dst;
                    if (plane == 0) dst = P + (size_t)row * pitch + hh * 64 + 8 * fq;
                    else { const int t = t0 + ai * HALF + m * 16; const int tpos = ((t & ((1 << lg) - 1)) << (11 - lg)) + (t >> lg); dst = P + ((size_t)(b * H + hh) * 2048 + tpos) * 64 + 8 * fq; }
#pragma unroll
                    for (int bj = 0; bj < 2; ++bj) { u32x4 w; w.x = cvt_pk_bf16(v[bj][0][0], v[bj][0][1]); w.y = cvt_pk_bf16(v[bj][0][2], v[bj][0][3]); w.z = cvt_pk_bf16(v[bj][1][0], v[bj][1][1]); w.w = cvt_pk_bf16(v[bj][1][2], v[bj][1][3]);
                        *(u32x4*)(dst + 32 * bj) = w; } }
        } else {
#pragma unroll
            for (int ai = 0; ai < 2; ++ai)
#pragma unroll
                for (int m = 0; m < 4; ++m) { const int t = t0 + ai * HALF + m * 16; const int tpos = ((t & ((1 << lg) - 1)) << (11 - lg)) + (t >> lg); const float r = rt[u.idx * 256 + ai * HALF + wr * 64 + m * 16 + fr];
#pragma unroll
                    for (int bj = 0; bj < 2; ++bj) { const int colb = ct * 256 + bj * HALF + wc * 32 + 8 * fq; const int hh = colb >> 6, d0 = colb & 63;
                        bf16_t* vp = P + (((size_t)(b * H + hh) * 64 + (tpos >> 5)) * 64 + d0) * 32 + (tpos & 31);
#pragma unroll
                        for (int n = 0; n < 2; ++n) { const f32x4 v = acc[ai][bj][m][n] * r; const unsigned w0 = cvt_pk_bf16(v[0], v[1]), w1 = cvt_pk_bf16(v[2], v[3]);
                            vp[(4 * n + 0) * 32] = (bf16_t)(w0 & 0xffffu); vp[(4 * n + 1) * 32] = (bf16_t)(w0 >> 16);
                            vp[(4 * n + 2) * 32] = (bf16_t)(w1 & 0xffffu); vp[(4 * n + 3) * 32] = (bf16_t)(w1 >> 16); } } }
        }
    }
};
template <int ACT> struct EpiAct {
    static constexpr bool PERM = true, AFTER_DRAIN = false;
    const PG8_LAS float* rt; bf16_t* __restrict__ O; int ldc;
    __device__ __forceinline__ float act(float x) const { if (ACT == 0) return __builtin_amdgcn_rcpf(1.0f + __builtin_amdgcn_exp2f(-1.4426950408889634f * x)); const float y = fmaxf(x, 0.f); return y * y; }
    __device__ __forceinline__ void operator()(const f32x4 (&acc)[2][2][4][2], const Unit& u, int wr, int wc, int fr, int fq) const {
        const int row0 = u.pm * BM + wr * 64 + fr, col0 = u.pn * BM + wc * 32 + 8 * fq;
#pragma unroll
        for (int ai = 0; ai < 2; ++ai)
#pragma unroll
            for (int m = 0; m < 4; ++m) { const int row = row0 + ai * HALF + m * 16; const float r = rt[u.idx * 256 + ai * HALF + wr * 64 + m * 16 + fr]; bf16_t* rowp = O + (size_t)row * ldc + col0;
#pragma unroll
                for (int bj = 0; bj < 2; ++bj) { const f32x4 v0 = acc[ai][bj][m][0] * r, v1 = acc[ai][bj][m][1] * r;
                    u32x4 w; w.x = cvt_pk_bf16(act(v0[0]), act(v0[1])); w.y = cvt_pk_bf16(act(v0[2]), act(v0[3])); w.z = cvt_pk_bf16(act(v1[0]), act(v1[1])); w.w = cvt_pk_bf16(act(v1[2]), act(v1[3]));
                    *(u32x4*)(rowp + bj * HALF) = w; } }
    }
};
struct EpiMerge {
    static constexpr bool PERM = true, AFTER_DRAIN = false;
    const bf16_t* __restrict__ G; bf16_t* __restrict__ O; int BR;
    __device__ __forceinline__ void operator()(const f32x4 (&acc)[2][2][4][2], const Unit& u, int wr, int wc, int fr, int fq) const {
        const int row0 = u.pm * BM + wr * 64 + fr, col0 = u.pn * BM + wc * 32 + 8 * fq;
#pragma unroll
        for (int ai = 0; ai < 2; ++ai) {
#pragma unroll
            for (int mp = 0; mp < 2; ++mp) {
                u32x4 g[2][2], p[2][2];
#pragma unroll
                for (int mm = 0; mm < 2; ++mm)
#pragma unroll
                    for (int bj = 0; bj < 2; ++bj) g[mm][bj] = *(const u32x4*)(G + (size_t)(row0 + ai * HALF + (2 * mp + mm) * 16) * 1024 + col0 + bj * HALF);
                if (BR > 0) {
#pragma unroll
                    for (int mm = 0; mm < 2; ++mm)
#pragma unroll
                        for (int bj = 0; bj < 2; ++bj) p[mm][bj] = *(const u32x4*)(O + (size_t)(row0 + ai * HALF + (2 * mp + mm) * 16) * 1024 + col0 + bj * HALF);
                } else {
#pragma unroll
                    for (int mm = 0; mm < 2; ++mm)
#pragma unroll
                        for (int bj = 0; bj < 2; ++bj) p[mm][bj] = (u32x4){0u, 0u, 0u, 0u};
                }
#pragma unroll
                for (int mm = 0; mm < 2; ++mm)
#pragma unroll
                    for (int bj = 0; bj < 2; ++bj) { const int m = 2 * mp + mm; const u32x4 gg = g[mm][bj], pp = p[mm][bj]; const f32x4 a0 = acc[ai][bj][m][0], a1 = acc[ai][bj][m][1];
                        const float o0 = a0[0] * bflo(gg.x) + bflo(pp.x), o1 = a0[1] * bfhi(gg.x) + bfhi(pp.x), o2 = a0[2] * bflo(gg.y) + bflo(pp.y), o3 = a0[3] * bfhi(gg.y) + bfhi(pp.y);
                        const float o4 = a1[0] * bflo(gg.z) + bflo(pp.z), o5 = a1[1] * bfhi(gg.z) + bfhi(pp.z), o6 = a1[2] * bflo(gg.w) + bflo(pp.w), o7 = a1[3] * bfhi(gg.w) + bfhi(pp.w);
                        u32x4 w; w.x = cvt_pk_bf16(o0, o1); w.y = cvt_pk_bf16(o2, o3); w.z = cvt_pk_bf16(o4, o5); w.w = cvt_pk_bf16(o6, o7);
                        *(u32x4*)(O + (size_t)(row0 + ai * HALF + m * 16) * 1024 + col0 + bj * HALF) = w; }
            }
        }
    }
};
struct EpiRes {
    static constexpr bool PERM = false, AFTER_DRAIN = false;
    const float* __restrict__ xin; float* __restrict__ xout; bf16_t* __restrict__ xn; const float* __restrict__ gain; float* __restrict__ ssq;
    __device__ __forceinline__ void operator()(const f32x4 (&acc)[2][2][4][2], const Unit& u, int wr, int wc, int fr, int fq) const {
        const int col0 = u.pn * BM + wc * 32 + 4 * fq; const bool nx = xn != nullptr;
        f32x4 gv[2][2];
#pragma unroll
        for (int bj = 0; bj < 2; ++bj)
#pragma unroll
            for (int n = 0; n < 2; ++n) gv[bj][n] = nx ? *(const f32x4*)(gain + col0 + bj * HALF + n * 16) : (f32x4){0.f, 0.f, 0.f, 0.f};
#pragma unroll
        for (int ai = 0; ai < 2; ++ai)
#pragma unroll
            for (int mp = 0; mp < 2; ++mp) {
                f32x4 xi[2][2][2];
#pragma unroll
                for (int mm = 0; mm < 2; ++mm) { const size_t off = (size_t)(u.pm * BM + ai * HALF + wr * 64 + (2 * mp + mm) * 16 + fr) * 1024 + col0;
#pragma unroll
                    for (int bj = 0; bj < 2; ++bj)
#pragma unroll
                        for (int n = 0; n < 2; ++n) xi[mm][bj][n] = *(const f32x4*)(xin + off + bj * HALF + n * 16); }
#pragma unroll
                for (int mm = 0; mm < 2; ++mm) { const int m = 2 * mp + mm; const int row = u.pm * BM + ai * HALF + wr * 64 + m * 16 + fr; const size_t off = (size_t)row * 1024 + col0; float s = 0.f;
#pragma unroll
                    for (int bj = 0; bj < 2; ++bj)
#pragma unroll
                        for (int n = 0; n < 2; ++n) { const f32x4 o = xi[mm][bj][n] + acc[ai][bj][m][n];
                            *(f32x4*)(xout + off + bj * HALF + n * 16) = o;
                            if (nx) { s += (o[0] * o[0] + o[1] * o[1]) + (o[2] * o[2] + o[3] * o[3]); const f32x4 y = o * gv[bj][n]; u32x2 w; w.x = cvt_pk_bf16(y[0], y[1]); w.y = cvt_pk_bf16(y[2], y[3]);
                                *(u32x2*)(xn + off + bj * HALF + n * 16) = w; } }
                    if (nx) { s += __shfl_xor(s, 16); s += __shfl_xor(s, 32); if (fq == 0) ssq[(size_t)row * 16 + u.pn * 4 + wc] = s; } }
            }
    }
};
template <class Epi, class Sched, bool ALIGN_EPI = false, bool SP2 = false>
__device__ __forceinline__ void gemm_phase(PG8_LAS unsigned char* lds, const Gemm g, const Sched& S, const Epi& E) {
    int tid_ = threadIdx.x; asm volatile("" : "+v"(tid_));
    const int tid = tid_, wid = __builtin_amdgcn_readfirstlane(tid >> 6), lane = tid & 63, wr = wid >> 2, wc = wid & 3, fr = lane & 15, fq = lane >> 4;
    const int K = g.K, nt = K / BK;
    unsigned voffA[2], voffB[2];
#pragma unroll
    for (int i = 0; i < 2; ++i) { int R, C; stage_rc(tid * 16 + i * 8192, R, C); const int Rb = Epi::PERM ? ((R & ~31) + perm32(R & 31)) : R;
        voffA[i] = (unsigned)(R * K + C) * 2u; voffB[i] = (unsigned)(Rb * K + C) * 2u; }
    const size_t kstep = (size_t)(BK * 2);
    const size_t hstep = (size_t)HALF * K * 2;
    const size_t tstep = 2 * hstep;
    const unsigned ldsw = (unsigned)wid * 1024u;
    const int aoff = lds_byte(wr * 64 + fr, fq * 8), boff = lds_byte(wc * 32 + fr, fq * 8);
#define PG8_SA(b, h) (((b) * 2 + (h)) * HTB)
#define PG8_SB(b, h) ((4 + (b) * 2 + (h)) * HTB)
#define PG8_STAGE(bufoff, gbase, voff) do { _Pragma("unroll") for (int _i = 0; _i < 2; ++_i) \
        __builtin_amdgcn_global_load_lds((const unsigned*)((const char*)(gbase) + (voff)[_i]), (PG8_LAS unsigned*)(lds + (bufoff) + ldsw + _i * 8192), 16, 0, 0); } while (0)
#define PG8_LDA(dst, b, h) do { _Pragma("unroll") for (int m = 0; m < 4; ++m) _Pragma("unroll") for (int k = 0; k < 2; ++k) dst[m][k] = *(const PG8_LAS bf16x8*)(lds + PG8_SA(b, h) + aoff + m * 2048 + k * 1024); } while (0)
#define PG8_LDB(dst, b, h) do { _Pragma("unroll") for (int n = 0; n < 2; ++n) _Pragma("unroll") for (int k = 0; k < 2; ++k) dst[n][k] = *(const PG8_LAS bf16x8*)(lds + PG8_SB(b, h) + boff + n * 2048 + k * 1024); } while (0)
#define PG8_MMA(ai, bj, At, Bt) do { __builtin_amdgcn_s_setprio(1); _Pragma("unroll") for (int m = 0; m < 4; ++m) _Pragma("unroll") for (int n = 0; n < 2; ++n) _Pragma("unroll") for (int k = 0; k < 2; ++k) \
        acc[ai][bj][m][n] = __builtin_amdgcn_mfma_f32_16x16x32_bf16(Bt[n][k], At[m][k], acc[ai][bj][m][n], 0, 0, 0); __builtin_amdgcn_s_setprio(0); } while (0)
#define PG8_WAIT_V(n) asm volatile("s_waitcnt vmcnt(" #n ")" ::: "memory")
#define PG8_WAIT_L(n) asm volatile("s_waitcnt lgkmcnt(" #n ")" ::: "memory")
#define PG8_BAR __builtin_amdgcn_s_barrier()
#define PG8_SCHED __builtin_amdgcn_sched_barrier(0)
    Unit cur, nxt; int ui = 0;
    if (!S.next(0, cur)) return;
    f32x4 acc[2][2][4][2];
#pragma unroll
    for (int a = 0; a < 2; ++a)
#pragma unroll
        for (int b = 0; b < 2; ++b)
#pragma unroll
            for (int m = 0; m < 4; ++m)
#pragma unroll
                for (int n = 0; n < 2; ++n) acc[a][b][m][n] = (f32x4){0.f, 0.f, 0.f, 0.f};
    bf16x8 At[4][2], B0[2][2], B1[2][2];
    const char* cA = (const char*)g.A + (size_t)cur.pm * tstep; const char* cB = (const char*)g.Bt + (size_t)cur.pn * tstep;
    S.a_ready(cur);
    if constexpr (SP2) {
        PG8_STAGE(PG8_SB(0, 0), cB, voffB); PG8_STAGE(PG8_SB(0, 1), cB + hstep, voffB); PG8_STAGE(PG8_SA(0, 0), cA, voffA); PG8_STAGE(PG8_SA(0, 1), cA + hstep, voffA);
        if (wr == 1) PG8_BAR;
        PG8_WAIT_V(2); PG8_BAR;
        PG8_STAGE(PG8_SB(1, 0), cB + kstep, voffB); PG8_STAGE(PG8_SA(1, 0), cA + kstep, voffA); PG8_STAGE(PG8_SB(1, 1), cB + hstep + kstep, voffB);
        PG8_WAIT_V(6); PG8_BAR;
    } else {
        PG8_STAGE(PG8_SB(0, 0), cB, voffB); PG8_STAGE(PG8_SA(0, 0), cA, voffA); PG8_STAGE(PG8_SB(0, 1), cB + hstep, voffB); PG8_STAGE(PG8_SA(0, 1), cA + hstep, voffA);
        if (wr == 1) PG8_BAR;
        PG8_WAIT_V(4); PG8_BAR;
        PG8_STAGE(PG8_SB(1, 0), cB + kstep, voffB); PG8_STAGE(PG8_SA(1, 0), cA + kstep, voffA); PG8_STAGE(PG8_SB(1, 1), cB + hstep + kstep, voffB);
        PG8_WAIT_V(6); PG8_BAR;
    }
    for (;;) {
        const bool has_next = S.next(ui + 1, nxt);
        const char* nA = has_next ? (const char*)g.A + (size_t)nxt.pm * tstep : cA; const char* nB = has_next ? (const char*)g.Bt + (size_t)nxt.pn * tstep : cB;
        for (int t = 0; t < nt; t += 2) {
            const bool last = (t == nt - 2);
            const char* a1 = cA + (size_t)(t + 1) * kstep;
            const char* a2 = last ? nA : cA + (size_t)(t + 2) * kstep; const char* b2 = last ? nB : cB + (size_t)(t + 2) * kstep;
            const char* a3 = a2 + kstep; const char* b3 = b2 + kstep;
            if (last && has_next) S.a_ready(nxt);
            if constexpr (SP2) {
            PG8_LDB(B0, 0, 0); PG8_LDB(B1, 0, 1); PG8_SCHED; PG8_LDA(At, 0, 0); PG8_STAGE(PG8_SA(1, 1), a1 + hstep, voffA);
            PG8_WAIT_V(8); PG8_WAIT_L(0); PG8_BAR; PG8_MMA(0, 0, At, B0); PG8_MMA(0, 1, At, B1); PG8_BAR; PG8_SCHED;
            PG8_LDA(At, 0, 1); PG8_STAGE(PG8_SB(0, 0), b2, voffB); PG8_STAGE(PG8_SB(0, 1), b2 + hstep, voffB); PG8_STAGE(PG8_SA(0, 0), a2, voffA);
            PG8_WAIT_V(8); PG8_WAIT_L(0); PG8_BAR; PG8_MMA(1, 0, At, B0); PG8_MMA(1, 1, At, B1); PG8_BAR; PG8_SCHED;
            PG8_LDB(B0, 1, 0); PG8_LDB(B1, 1, 1); PG8_SCHED; PG8_LDA(At, 1, 0); PG8_STAGE(PG8_SA(0, 1), a2 + hstep, voffA);
            PG8_WAIT_V(8); PG8_WAIT_L(0); PG8_BAR; PG8_MMA(0, 0, At, B0); PG8_MMA(0, 1, At, B1); PG8_BAR; PG8_SCHED;
            PG8_LDA(At, 1, 1); PG8_STAGE(PG8_SB(1, 0), b3, voffB); PG8_STAGE(PG8_SB(1, 1), b3 + hstep, voffB); PG8_STAGE(PG8_SA(1, 0), a3, voffA);
            PG8_WAIT_V(8); PG8_WAIT_L(0); PG8_BAR; PG8_MMA(1, 0, At, B0); PG8_MMA(1, 1, At, B1); PG8_BAR; PG8_SCHED;
            } else {
            PG8_LDB(B0, 0, 0); PG8_SCHED; PG8_LDA(At, 0, 0); PG8_STAGE(PG8_SA(1, 1), a1 + hstep, voffA);
            PG8_WAIT_L(8); PG8_BAR; PG8_WAIT_L(0); PG8_MMA(0, 0, At, B0); PG8_BAR; PG8_SCHED;
            PG8_LDB(B1, 0, 1); PG8_STAGE(PG8_SB(0, 0), b2, voffB);
            PG8_BAR; PG8_WAIT_L(0); PG8_MMA(0, 1, At, B1); PG8_BAR;
            PG8_LDA(At, 0, 1); PG8_STAGE(PG8_SA(0, 0), a2, voffA);
            PG8_BAR; PG8_WAIT_L(0); PG8_MMA(1, 0, At, B0); PG8_BAR; PG8_SCHED;
            PG8_STAGE(PG8_SB(0, 1), b2 + hstep, voffB);
            PG8_WAIT_V(6); PG8_BAR; PG8_MMA(1, 1, At, B1); PG8_BAR;
            PG8_LDB(B0, 1, 0); PG8_SCHED; PG8_LDA(At, 1, 0); PG8_STAGE(PG8_SA(0, 1), a2 + hstep, voffA);
            PG8_WAIT_L(8); PG8_BAR; PG8_WAIT_L(0); PG8_MMA(0, 0, At, B0); PG8_BAR; PG8_SCHED;
            PG8_LDB(B1, 1, 1); PG8_STAGE(PG8_SB(1, 0), b3, voffB);
            PG8_BAR; PG8_WAIT_L(0); PG8_MMA(0, 1, At, B1); PG8_BAR;
            PG8_LDA(At, 1, 1); PG8_STAGE(PG8_SA(1, 0), a3, voffA);
            PG8_BAR; PG8_WAIT_L(0); PG8_MMA(1, 0, At, B0); PG8_BAR; PG8_SCHED;
            PG8_STAGE(PG8_SB(1, 1), b3 + hstep, voffB);
            PG8_WAIT_V(6); PG8_BAR; PG8_MMA(1, 1, At, B1); PG8_BAR;
            }
        }
        if constexpr (ALIGN_EPI) { if (wr == 0) PG8_BAR; }
        if constexpr (!Epi::AFTER_DRAIN) { E(acc, cur, wr, wc, fr, fq); S.done(cur); }
        if (!has_next) break;
#pragma unroll
        for (int a = 0; a < 2; ++a)
#pragma unroll
            for (int b = 0; b < 2; ++b)
#pragma unroll
                for (int m = 0; m < 4; ++m)
#pragma unroll
                    for (int n = 0; n < 2; ++n) acc[a][b][m][n] = (f32x4){0.f, 0.f, 0.f, 0.f};
        cur = nxt; cA = nA; cB = nB; ++ui;
        if constexpr (ALIGN_EPI) { if (wr == 1) PG8_BAR; }
    }
    PG8_WAIT_V(0);
    if constexpr (!ALIGN_EPI) { if (wr == 0) PG8_BAR; }
    PG8_BAR;
    if constexpr (Epi::AFTER_DRAIN) { E.fused(acc, cur, wr, wc, fr, fq, lds, wid, lane); S.done(cur); }
#undef PG8_SA
#undef PG8_SB
#undef PG8_STAGE
#undef PG8_LDA
#undef PG8_LDB
#undef PG8_MMA
#undef PG8_WAIT_V
#undef PG8_WAIT_L
#undef PG8_BAR
#undef PG8_SCHED
}
}

#define GAS __attribute__((address_space(1)))
#define LAS __attribute__((address_space(3)))
typedef unsigned short bf16;
typedef unsigned v4u __attribute__((ext_vector_type(4)));
typedef unsigned v2u __attribute__((ext_vector_type(2)));
typedef float f32x4 __attribute__((ext_vector_type(4)));
typedef float f32x16 __attribute__((ext_vector_type(16)));
typedef short bf16x8 __attribute__((ext_vector_type(8)));
#define LDS_WAIT() asm volatile("s_waitcnt lgkmcnt(0)" ::: "memory")

struct Args { const void* in[16]; float* out; unsigned char* ws; int ph_lo, ph_hi; };

struct Frame {
    LAS unsigned char* lds; unsigned char* ws; int tid, lane, wave, G, gw, NGW;
};
#define IN_X(a)        ((const float*)(a).in[0])
#define IN_POS(a)      ((const int*)(a).in[1])
#define IN_ATTN_NORM(a) ((const float*)(a).in[2])
#define IN_W_IN(a)     ((const float*)(a).in[3])
#define IN_B_FORGET(a) ((const float*)(a).in[4])
#define IN_QNF(a)      ((const float*)(a).in[5])
#define IN_KNF(a)      ((const float*)(a).in[6])
#define IN_QND(a)      ((const float*)(a).in[7])
#define IN_KND(a)      ((const float*)(a).in[8])
#define IN_W_UP_FOX(a) ((const float*)(a).in[9])
#define IN_W_UP_SB(a)  ((const float*)(a).in[10])
#define IN_W_UP_DIL(a) ((const float*)(a).in[11])
#define IN_W_OUT(a)    ((const float*)(a).in[12])
#define IN_MLP_NORM(a) ((const float*)(a).in[13])
#define IN_W_MLP_IN(a) ((const float*)(a).in[14])
#define IN_W_MLP_OUT(a) ((const float*)(a).in[15])
__device__ __forceinline__ unsigned f2bf(float f) { unsigned u = __builtin_bit_cast(unsigned, f); return (u + 0x7fffu + ((u >> 16) & 1u)) >> 16; }
typedef float f32x2_t __attribute__((ext_vector_type(2))); typedef __bf16 bf16x2_t __attribute__((ext_vector_type(2)));
__device__ __forceinline__ unsigned cvtpk(float lo, float hi) { f32x2_t v = {lo, hi}; bf16x2_t b = __builtin_convertvector(v, bf16x2_t); return __builtin_bit_cast(unsigned, b); }
__device__ __forceinline__ unsigned pk2(float lo, float hi) { return cvtpk(lo, hi); }
__device__ __forceinline__ float blo(unsigned w) { return __uint_as_float(w << 16); }
__device__ __forceinline__ float bhi(unsigned w) { return __uint_as_float(w & 0xffff0000u); }
__device__ __forceinline__ float wave_sum(float v) {
#pragma unroll
    for (int o = 1; o < 64; o <<= 1) v += __shfl_xor(v, o);
    return v;
}

__device__ __forceinline__ void tr_item(const float* W, int pitch, int K, bf16* WT, int nblk, float scale, LAS float* scr, int item, int lane, bool perm = false) {
    const int kb = item / nblk, nb = item % nblk, k0 = 64 * kb, n0 = 32 * nb;
    const int s0 = perm ? (n0 & ~255) + ((n0 >> 5) & 3) * 64 + ((n0 >> 7) & 1) * 32 : n0;
#pragma unroll 8
    for (int i = 0; i < 32; ++i) { const int kk = 2 * i + (lane >> 5); scr[kk * 33 + (lane & 31)] = W[(size_t)(k0 + kk) * pitch + s0 + (lane & 31)]; }
    LDS_WAIT(); asm volatile("" ::: "memory");
    const int c = lane & 7;
#pragma unroll
    for (int j = 0; j < 4; ++j) { const int n = (lane >> 3) + 8 * j; const LAS float* s = scr + (8 * c) * 33 + n;
        v4u o; o.x = pk2(s[0 * 33] * scale, s[1 * 33] * scale); o.y = pk2(s[2 * 33] * scale, s[3 * 33] * scale); o.z = pk2(s[4 * 33] * scale, s[5 * 33] * scale); o.w = pk2(s[6 * 33] * scale, s[7 * 33] * scale);
        *(v4u*)(WT + (size_t)(n0 + n) * K + k0 + 8 * c) = o; }
    LDS_WAIT(); asm volatile("" ::: "memory");
}
__device__ __forceinline__ void p0_prologue(const Frame& F, const Args& A) {
    LAS float* scr = (LAS float*)(F.lds + F.wave * 16384);
    if (blockIdx.x == 0 && F.tid < DEPTH) ((unsigned*)(F.ws + WS_CTL))[F.tid * 64] = 0u;
    for (int it = F.gw; it < DEPTH * ITEMS_PER_LAYER; it += F.NGW) {
        const int layer = it / ITEMS_PER_LAYER; int r = it % ITEMS_PER_LAYER;
        unsigned char* wl = F.ws + WS_W + (size_t)layer * WL_STRIDE;
        const float* win = IN_W_IN(A) + (size_t)layer * DMODEL * DIN;
        bf16* wq = (bf16*)(wl + WL_QKV);
        if (r < 512) { tr_item(win, DIN, 1024, wq, 32, 1.f, scr, r, F.lane, true); continue; } r -= 512;
        if (r < 256) { tr_item(win + 1024, DIN, 1024, wq + (size_t)1024 * 1024, 16, 1.f, scr, r, F.lane); continue; } r -= 256;
        if (r < 256) { tr_item(win + 1544, DIN, 1024, wq + (size_t)1536 * 1024, 16, C2, scr, r, F.lane, true); continue; } r -= 256;
        if (r < 256) { tr_item(win + 2056, DIN, 1024, wq + (size_t)2048 * 1024, 16, 1.f, scr, r, F.lane, true); continue; } r -= 256;
        if (r < 256) { tr_item(win + 2568, DIN, 1024, wq + (size_t)2560 * 1024, 16, 1.f, scr, r, F.lane); continue; } r -= 256;
        if (r < 768) { tr_item(win + 3080, DIN, 1024, wq + (size_t)3072 * 1024, 48, 1.f, scr, r, F.lane, true); continue; } r -= 768;
        if (r < 384) { tr_item(win + 4616, DIN, 1024, wq + (size_t)4608 * 1024, 24, 1.f, scr, r, F.lane); continue; } r -= 384;
        if (r < 1536) { tr_item(win + 5384, DIN, 1024, (bf16*)(wl + WL_G), 96, 1.f, scr, r, F.lane); continue; } r -= 1536;
        if (r < 256) { tr_item(IN_W_UP_FOX(A) + (size_t)layer * 512 * 1024, 1024, 512, (bf16*)(wl + WL_A), 32, 1.f, scr, r, F.lane); continue; } r -= 256;
        if (r < 256) { tr_item(IN_W_UP_SB(A) + (size_t)layer * 512 * 1024, 1024, 512, (bf16*)(wl + WL_B), 32, 1.f, scr, r, F.lane); continue; } r -= 256;
        if (r < 128) { tr_item(IN_W_UP_DIL(A) + (size_t)layer * 256 * 1024, 1024, 256, (bf16*)(wl + WL_C), 32, 1.f, scr, r, F.lane); continue; } r -= 128;
        if (r < 512) { tr_item(IN_W_OUT(A) + (size_t)layer * 1024 * 1024, 1024, 1024, (bf16*)(wl + WL_O), 32, 1.f, scr, r, F.lane); continue; } r -= 512;
        if (r < 2048) { tr_item(IN_W_MLP_IN(A) + (size_t)layer * 1024 * 4096, 4096, 1024, (bf16*)(wl + WL_MI), 128, 1.f, scr, r, F.lane); continue; } r -= 2048;
        tr_item(IN_W_MLP_OUT(A) + (size_t)layer * 4096 * 1024, 1024, 4096, (bf16*)(wl + WL_MO), 32, 1.f, scr, r, F.lane);
    }
    bf16* XN = (bf16*)(F.ws + WS_R0); float* SSQ = (float*)(F.ws + WS_SSQ);
    for (int m = F.gw; m < M; m += F.NGW) {
        const f32x4* xr = (const f32x4*)(IN_X(A) + (size_t)m * DMODEL) + F.lane; const f32x4* gr = (const f32x4*)IN_ATTN_NORM(A) + F.lane;
        unsigned long long* o8 = (unsigned long long*)(XN + (size_t)m * DMODEL) + F.lane; float s = 0.f;
#pragma unroll
        for (int j = 0; j < 4; ++j) { const f32x4 v = xr[64 * j], g = gr[64 * j]; s += (v.x * v.x + v.y * v.y) + (v.z * v.z + v.w * v.w);
            o8[64 * j] = (unsigned long long)pk2(v.x * g.x, v.y * g.y) | ((unsigned long long)pk2(v.z * g.z, v.w * g.w) << 32); }
        s = wave_sum(s);
        if (F.lane < 16) SSQ[(size_t)m * 16 + F.lane] = F.lane == 0 ? s : 0.f;
    }
    if (F.gw == 0) { float* GN = (float*)(F.ws + WS_GAIN);
        for (int l = 0; l < DEPTH; ++l) { GN[l * 256 + F.lane] = IN_QNF(A)[l * 64 + F.lane]; GN[l * 256 + 64 + F.lane] = IN_KNF(A)[l * 64 + F.lane]; GN[l * 256 + 128 + F.lane] = IN_QND(A)[l * 64 + F.lane]; GN[l * 256 + 192 + F.lane] = IN_KND(A)[l * 64 + F.lane]; } }
    { float* COS = (float*)(F.ws + WS_COS); float* SIN = (float*)(F.ws + WS_SIN);
      for (int idx = F.gw * 64 + F.lane; idx < M * 32; idx += F.NGW * 64) { const int mrow = idx >> 5, i = idx & 31;
          const float a = (float)IN_POS(A)[mrow] * exp2f(-(float)i * (13.287712379549449f / 32.0f)); float sn, cs; sincosf(a, &sn, &cs); COS[idx] = cs; SIN[idx] = sn; } }
}

__device__ __forceinline__ void p1_forget(const Frame& F, const Args& A, int layer) {
    LAS bf16* wfb = (LAS bf16*)F.lds;
    LAS float* lfb = (LAS float*)(F.lds + 32768);
    const float* win = IN_W_IN(A) + (size_t)layer * DMODEL * DIN;
    if (blockIdx.x == 0 && F.tid < 3) ((unsigned*)(F.ws + WS_CTL))[F.tid == 0 ? layer * 64 : F.tid == 1 ? layer * 64 + 16 : 32] = 0u;
    const int G_ = (int)gridDim.x, rem_ = ((M / 256) * (NQKV / 256)) % G_;
    const int c0_ = rem_ == 0 ? (int)blockIdx.x : (int)blockIdx.x - rem_, cs_ = rem_ == 0 ? G_ : G_ - rem_;
    if (c0_ < 0) return;
    for (int idx = F.tid; idx < 8192; idx += 512) { const int k = idx >> 3, j = idx & 7; wfb[j * 1056 + k] = (bf16)f2bf(win[(size_t)k * DIN + 1536 + j]); }
    __syncthreads();
    const int lane = F.lane;
    const float bfor = IN_B_FORGET(A)[layer * 8 + (lane & 7)];
    const bf16* XN = (const bf16*)(F.ws + WS_R0); const float* SSQ = (const float*)(F.ws + WS_SSQ);
    float* LFS = (float*)(F.ws + WS_LFS); float* CTOT = (float*)(F.ws + WS_CTOT);
    for (int chunk = c0_; chunk < M / 128; chunk += cs_) {
        {
            typedef float f32x4m __attribute__((ext_vector_type(4)));
            const size_t row0 = (size_t)chunk * 128 + F.wave * 16; const int mr = lane & 15, kg = lane >> 4;
            const bf16* xa = XN + (row0 + mr) * DMODEL + 8 * kg; const LAS bf16* wb = wfb + (mr & 7) * 1056 + 8 * kg;
            f32x4m acc = {0.f, 0.f, 0.f, 0.f};
#pragma unroll 4
            for (int s = 0; s < 32; ++s) { const bf16x8 af = *(const bf16x8*)(xa + 32 * s); bf16x8 bfr = *(const LAS bf16x8*)(wb + 32 * s);
                if (mr >= 8) bfr = (bf16x8){0, 0, 0, 0, 0, 0, 0, 0};
                acc = __builtin_amdgcn_mfma_f32_16x16x32_bf16(af, bfr, acc, 0, 0, 0); }
            if (mr < 8) {
#pragma unroll
                for (int r = 0; r < 4; ++r) { const int rr = 4 * kg + r; const float y = acc[r] * pg8::row_rstd(SSQ, (int)(row0 + rr)) + bfor;
                    lfb[(F.wave * 16 + rr) * 8 + mr] = -(fmaxf(-y, 0.f) + log1pf(expf(-fabsf(y)))); } }
        }
        __syncthreads();
        if (F.wave == 0) {
            const int j = lane & 7, seg = lane >> 3; float run = 0.f;
#pragma unroll
            for (int i = 0; i < 16; ++i) { run += lfb[(seg * 16 + i) * 8 + j]; lfb[(seg * 16 + i) * 8 + j] = run; }
            float off = 0.f;
#pragma unroll
            for (int s = 1; s < 8; ++s) { const float o = __shfl_up(run, 8 * s); if (seg >= s) off += o; }
            const int b = chunk >> 4, t0 = (chunk & 15) * 128 + seg * 16;
#pragma unroll
            for (int i = 0; i < 16; ++i) LFS[((size_t)(b * 8 + j)) * 2048 + t0 + i] = lfb[(seg * 16 + i) * 8 + j] + off;
            if (seg == 7) CTOT[chunk * 8 + j] = off + run;
        }
        __syncthreads();
    }
}

template <int KIND> __device__ __forceinline__ void coop_block(const Frame& F, const float* gq_, const float* gk_, int b, int hh, int lg, int c, int QB) {
    const int tid = F.tid, lane = F.lane, w = F.wave, q = lane & 31, hi = lane >> 5;
    constexpr int H = KIND == 2 ? 12 : 8, pitch = KIND == 2 ? 768 : 512;
    bf16* Qp = (bf16*)(F.ws + (KIND == 0 ? WS_SBQ : KIND == 1 ? WS_FOXQ : WS_DILQ));
    const bf16* Kp = (const bf16*)(F.ws + (KIND == 0 ? WS_SBK : KIND == 1 ? WS_FOXK : WS_DILK));
    const bf16* Vt = (const bf16*)(F.ws + (KIND == 0 ? WS_SBV : KIND == 1 ? WS_FOXV : WS_DILV));
    const int Ls_ = 2048 >> lg, NTS = Ls_ >> 5;
    const int qt = 8 * QB + w; const bool wave_on = qt < NTS;
    const int base = 8 * QB, TMAX = (base + 7 < NTS - 1) ? base + 7 : NTS - 1;
    const int tq = c + ((32 * (wave_on ? qt : 0) + q) << lg);
    bf16* qrow = Qp + ((size_t)b * 2048 + tq) * pitch + hh * 64;
    bf16x8 qf[4];
#pragma unroll
    for (int d0 = 0; d0 < 4; ++d0) qf[d0] = *(const bf16x8*)(qrow + 16 * d0 + 8 * hi);
    const bool ldk = tid < 256; const int t2 = tid & 255;
    const int ki = t2 >> 3, kch = t2 & 7, kpi = (ki & 19) | ((ki & 4) << 1) | ((ki & 8) >> 1);
    const int vd = t2 >> 2, vc = t2 & 3;
    const bf16* gsrc = ldk ? Kp + ((size_t)(b * H + hh) * 2048 + c * Ls_ + kpi) * 64 + 8 * kch : Vt + ((size_t)(b * H + hh) * 64 + (c * Ls_ >> 5)) * 2048 + vd * 32 + 8 * vc;
    const int ldst = ldk ? ki * 128 + ((kch ^ ((ki >> 1) & 7)) << 4) : 49152 + vd * 64 + ((vc ^ ((vd >> 2) & 3)) << 4);
    int koff[4], voff[2][2];
#pragma unroll
    for (int d0 = 0; d0 < 4; ++d0) koff[d0] = q * 128 + (((2 * d0 + hi) ^ ((q >> 1) & 7)) << 4);
#pragma unroll
    for (int dh = 0; dh < 2; ++dh)
#pragma unroll
        for (int s2 = 0; s2 < 2; ++s2) { const int d = q + 32 * dh; voff[dh][s2] = 49152 + d * 64 + (((2 * s2 + hi) ^ ((d >> 2) & 3)) << 4); }
    float offs = 0.f; const float* lfrow = nullptr; f32x4 bs[4]; float Bq = 0.f;
    if (KIND == 1) {
        float gq = fabsf(gq_[lane]), gk = fabsf(gk_[lane]);
#pragma unroll
        for (int o = 1; o < 64; o <<= 1) { gq = fmaxf(gq, __shfl_xor(gq, o)); gk = fmaxf(gk, __shfl_xor(gk, o)); }
        Bq = 64.f * C2 * gq * gk * 1.02f + 0.01f; }
    if (KIND == 1) { const float ct = lane < 16 ? ((const float*)(F.ws + WS_CTOT))[(b * 16 + lane) * 8 + hh] : 0.f; float inc = ct;
#pragma unroll
        for (int o = 1; o < 16; o <<= 1) { const float t = __shfl_up(inc, o); if (lane >= o) inc += t; }
        offs = inc - ct;
        lfrow = (const float*)(F.ws + WS_LFS) + (size_t)(b * 8 + hh) * 2048 + 8 * hi;
#pragma unroll
        for (int g = 0; g < 4; ++g) bs[g] = *(const f32x4*)(lfrow + 32 * qt + 16 * (g >> 1) + 4 * (g & 1)); }
    f32x16 o0, o1;
#pragma unroll
    for (int r = 0; r < 16; ++r) { o0[r] = 0.f; o1[r] = 0.f; }
    float m = -1e30f, lsum = 0.f, carry = 0.f; bool done = !wave_on;
    LAS unsigned char* L = F.lds; LAS int* flg = (LAS int*)(L + 98304);
#define NEW_TILE(I) (KIND == 2 ? base + 3 + (I) : base - (I))
#define NEW_OK(I) (KIND == 2 ? ((I) <= 4 && NEW_TILE(I) <= TMAX) : (NEW_TILE(I) >= 0))
    { v4u r8[8]; const int f0 = KIND == 2 ? base - 4 : base;
#pragma unroll
      for (int k = 0; k < 8; ++k) { const int tl = f0 + k; if (tl >= 0 && tl <= TMAX) r8[k] = *(const v4u*)(gsrc + (size_t)2048 * tl); }
#pragma unroll
      for (int k = 0; k < 8; ++k) { const int tl = f0 + k; if (tl >= 0 && tl <= TMAX) *(LAS v4u*)(L + 4096 * (tl % 12) + ldst) = r8[k]; } }
    v4u rS = (v4u){0u, 0u, 0u, 0u};
    if (NEW_OK(1)) rS = *(const v4u*)(gsrc + (size_t)2048 * NEW_TILE(1));
    __syncthreads();
    const int NI = KIND == 2 ? 5 : base + 8;
    for (int j = 0; j < NI; ++j) {
        if (NEW_OK(j + 1)) *(LAS v4u*)(L + 4096 * (NEW_TILE(j + 1) % 12) + ldst) = rS;
        if (NEW_OK(j + 2)) rS = *(const v4u*)(gsrc + (size_t)2048 * NEW_TILE(j + 2));
        const int t = KIND == 2 ? qt - 4 + j : qt - j;
        if (KIND != 2 && t < 0) done = true;
        const bool act = wave_on && t >= 0 && (KIND == 2 || !done);
        if (act) {
            const LAS unsigned char* Ls = L + 4096 * (t % 12);
            f32x16 s;
            float bnd = 0.f;
            if (KIND == 1) { const float off = __builtin_bit_cast(float, __builtin_amdgcn_readlane(__builtin_bit_cast(int, offs), t >> 2));
                bnd = Bq - (__builtin_bit_cast(float, __builtin_amdgcn_readlane(__builtin_bit_cast(int, bs[0].x), 0)) + off) * LOG2E;
#pragma unroll
                for (int g = 0; g < 4; ++g) { const f32x4 f = bs[g];
                    s[4 * g] = -(f.x + off) * LOG2E; s[4 * g + 1] = -(f.y + off) * LOG2E; s[4 * g + 2] = -(f.z + off) * LOG2E; s[4 * g + 3] = -(f.w + off) * LOG2E; }
                if (t > 0) {
#pragma unroll
                    for (int g = 0; g < 4; ++g) bs[g] = *(const f32x4*)(lfrow + 32 * (t - 1) + 16 * (g >> 1) + 4 * (g & 1)); }
            } else {
#pragma unroll
                for (int r = 0; r < 16; ++r) s[r] = 0.f;
            }
#pragma unroll
            for (int d0 = 0; d0 < 4; ++d0) { const bf16x8 kf = *(const LAS bf16x8*)(Ls + koff[d0]); s = __builtin_amdgcn_mfma_f32_32x32x16_bf16(kf, qf[d0], s, 0, 0, 0); }
            float p[16];
            if (KIND == 0) {
                float ln[16];
#pragma unroll
                for (int r = 0; r < 16; ++r) { const float z = s[r]; ln[r] = -(fmaxf(z, 0.f) + __builtin_amdgcn_logf(1.f + __builtin_amdgcn_exp2f(-fabsf(z)))); }
                if (t == qt) {
#pragma unroll
                    for (int r = 0; r < 16; ++r) if (16 * (r >> 3) + 8 * hi + (r & 7) >= q) ln[r] = 0.f;
                }
                float S0 = 0.f, S1 = 0.f;
#pragma unroll
                for (int e = 0; e < 8; ++e) { S0 += ln[e]; S1 += ln[8 + e]; }
                const float X0 = __shfl_xor(S0, 32), X1 = __shfl_xor(S1, 32);
                float run0 = carry + X1 + S1 + (hi == 0 ? X0 : 0.f), run1 = carry + (hi == 0 ? X1 : 0.f);
#pragma unroll
                for (int e = 7; e >= 0; --e) { run0 += ln[e]; p[e] = __builtin_amdgcn_exp2f(s[e] + run0); run1 += ln[8 + e]; p[8 + e] = __builtin_amdgcn_exp2f(s[8 + e] + run1); }
                if (t == qt) {
#pragma unroll
                    for (int r = 0; r < 16; ++r) if (16 * (r >> 3) + 8 * hi + (r & 7) >= q) p[r] = 0.f;
                }
                carry += (S0 + S1) + (X0 + X1);
                if (__all(carry < -160.f) || t == 0) done = true;
            } else {
                if (t == qt) {
#pragma unroll
                    for (int r = 0; r < 16; ++r) if (16 * (r >> 3) + 8 * hi + (r & 7) > q) s[r] = -1e30f;
                }
                if (KIND == 2 && t + 4 == qt) {
#pragma unroll
                    for (int r = 0; r < 16; ++r) if (16 * (r >> 3) + 8 * hi + (r & 7) < q) s[r] = -1e30f;
                }
                float tm = s[0];
#pragma unroll
                for (int r = 1; r < 16; ++r) tm = fmaxf(tm, s[r]);
                tm = fmaxf(tm, __shfl_xor(tm, 32));
                const float mn = fmaxf(m, tm), alpha = __builtin_amdgcn_exp2f(m - mn); m = mn;
                float ps = 0.f;
#pragma unroll
                for (int r = 0; r < 16; ++r) { p[r] = __builtin_amdgcn_exp2f(s[r] - mn); ps += p[r]; }
                lsum = lsum * alpha + ps;
#pragma unroll
                for (int r = 0; r < 16; ++r) { o0[r] *= alpha; o1[r] *= alpha; }
                if (KIND == 1 && (__all(bnd - m < -150.f) || t == 0)) done = true;
            }
            v4u w0, w1; w0.x = cvtpk(p[0], p[1]); w0.y = cvtpk(p[2], p[3]); w0.z = cvtpk(p[4], p[5]); w0.w = cvtpk(p[6], p[7]);
            w1.x = cvtpk(p[8], p[9]); w1.y = cvtpk(p[10], p[11]); w1.z = cvtpk(p[12], p[13]); w1.w = cvtpk(p[14], p[15]);
            const bf16x8 pb0 = __builtin_bit_cast(bf16x8, w0), pb1 = __builtin_bit_cast(bf16x8, w1);
            { const bf16x8 v00 = *(const LAS bf16x8*)(Ls + voff[0][0]), v01 = *(const LAS bf16x8*)(Ls + voff[0][1]), v10 = *(const LAS bf16x8*)(Ls + voff[1][0]), v11 = *(const LAS bf16x8*)(Ls + voff[1][1]);
              o0 = __builtin_amdgcn_mfma_f32_32x32x16_bf16(v00, pb0, o0, 0, 0, 0); o0 = __builtin_amdgcn_mfma_f32_32x32x16_bf16(v01, pb1, o0, 0, 0, 0);
              o1 = __builtin_amdgcn_mfma_f32_32x32x16_bf16(v10, pb0, o1, 0, 0, 0); o1 = __builtin_amdgcn_mfma_f32_32x32x16_bf16(v11, pb1, o1, 0, 0, 0); }
        }
        if (KIND != 2) { if (lane == 0) flg[(j & 1) * 8 + w] = done ? 0 : 1; }
        __syncthreads();
        if (KIND != 2) { const LAS int* fp = flg + (j & 1) * 8; const int any = fp[0] | fp[1] | fp[2] | fp[3] | fp[4] | fp[5] | fp[6] | fp[7]; if (any == 0) break; }
    }
#undef NEW_TILE
#undef NEW_OK
    if (wave_on) {
        float inv = 1.0f;
        if (KIND != 0) { lsum += __shfl_xor(lsum, 32); inv = 1.0f / lsum;
            if (KIND == 2 && hi == 0) ((float*)(F.ws + WS_LSE))[((size_t)b * 2048 + tq) * 12 + hh] = m + __builtin_amdgcn_logf(lsum); }
#pragma unroll
        for (int g = 0; g < 4; ++g) { v2u a; a.x = cvtpk(o0[4 * g] * inv, o0[4 * g + 1] * inv); a.y = cvtpk(o0[4 * g + 2] * inv, o0[4 * g + 3] * inv); *(v2u*)(qrow + 8 * g + 4 * hi) = a;
            v2u bq; bq.x = cvtpk(o1[4 * g] * inv, o1[4 * g + 1] * inv); bq.y = cvtpk(o1[4 * g + 2] * inv, o1[4 * g + 3] * inv); *(v2u*)(qrow + 32 + 8 * g + 4 * hi) = bq; }
    }
    __syncthreads();
}
constexpr int N_Q_UNITS = 1024 + 1024 + 512 + 512 + 1024;
__device__ __forceinline__ void p3_attention(const Frame& F, const Args& A, int layer) {
    const float* gq_ = IN_QNF(A) + layer * 64; const float* gk_ = IN_KNF(A) + layer * 64;
    unsigned* ctr = (unsigned*)(F.ws + WS_CTL) + layer * 64;
    LAS unsigned* uq = (LAS unsigned*)(F.lds + 98304 + 128);
    if (F.tid == 0) uq[0] = atomicAdd(ctr, 1u);
    __syncthreads();
    unsigned u = uq[0];
    for (;;) {
        if (u >= (unsigned)N_Q_UNITS) break;
        unsigned nxtu = 0u; if (F.tid == 0) nxtu = atomicAdd(ctr, 1u);
        if (u < 1024u) { const int QB = 7 - (int)(u >> 7), bh = u & 127; coop_block<1>(F, gq_, gk_, bh >> 3, bh & 7, 0, 0, QB); }
        else if (u < 2048u) { const int d = u - 1024; const int QB = 7 - (d >> 7), bh = d & 127; coop_block<0>(F, nullptr, nullptr, bh >> 3, bh & 7, 0, 0, QB); }
        else if (u < 2560u) { const int d = u - 2048; const int QB = 7 - (d >> 6), bj = d & 63; coop_block<2>(F, nullptr, nullptr, bj >> 2, bj & 3, 0, 0, QB); }
        else if (u < 3072u) { const int d = u - 2560; const int half = 1 - (d >> 8), r = d & 255; coop_block<2>(F, nullptr, nullptr, r >> 4, 4 + ((r >> 2) & 3), 2, r & 3, half); }
        else { const int d = u - 3072; coop_block<2>(F, nullptr, nullptr, d >> 6, 8 + ((d >> 4) & 3), 4, d & 15, 0); }
        if (F.tid == 0) uq[0] = nxtu;
        __syncthreads();
        u = uq[0];
    }
}
__device__ __forceinline__ void p4_combine(const Frame& F) {
    const float* LSE = (const float*)(F.ws + WS_LSE); const bf16* O = (const bf16*)(F.ws + WS_DILQ); bf16* OC = (bf16*)(F.ws + WS_OC);
    for (int pair = F.gw; pair < M / 2; pair += F.NGW) {
        const size_t tok = (size_t)2 * pair + (F.lane >> 5); const int sub = F.lane & 31, j = sub >> 3, d0 = (sub & 7) * 8;
        const float l0 = LSE[tok * 12 + j], l1 = LSE[tok * 12 + 4 + j], l2 = LSE[tok * 12 + 8 + j]; const float mx = fmaxf(l0, fmaxf(l1, l2));
        float w0 = __builtin_amdgcn_exp2f(l0 - mx), w1 = __builtin_amdgcn_exp2f(l1 - mx), w2 = __builtin_amdgcn_exp2f(l2 - mx); const float inv = 1.0f / (w0 + w1 + w2); w0 *= inv; w1 *= inv; w2 *= inv;
        const v4u a = *(const v4u*)(O + tok * 768 + j * 64 + d0), bq = *(const v4u*)(O + tok * 768 + (4 + j) * 64 + d0), cq = *(const v4u*)(O + tok * 768 + (8 + j) * 64 + d0);
        v4u o;
        o.x = pk2(w0 * blo(a.x) + w1 * blo(bq.x) + w2 * blo(cq.x), w0 * bhi(a.x) + w1 * bhi(bq.x) + w2 * bhi(cq.x));
        o.y = pk2(w0 * blo(a.y) + w1 * blo(bq.y) + w2 * blo(cq.y), w0 * bhi(a.y) + w1 * bhi(bq.y) + w2 * bhi(cq.y));
        o.z = pk2(w0 * blo(a.z) + w1 * blo(bq.z) + w2 * blo(cq.z), w0 * bhi(a.z) + w1 * bhi(bq.z) + w2 * bhi(cq.z));
        o.w = pk2(w0 * blo(a.w) + w1 * blo(bq.w) + w2 * blo(cq.w), w0 * bhi(a.w) + w1 * bhi(bq.w) + w2 * bhi(cq.w));
        *(v4u*)(OC + tok * 256 + j * 64 + d0) = o;
    }
}


__device__ const int PROG[] = {0, 1, 3, 4, 5, 6, 7, 8, 9, 11, 12, 13, 14, 15, 16};
constexpr int NPROG = sizeof(PROG) / sizeof(int);
typedef GAS unsigned gu32;
#define XB_TMO      128
#define XB_XCNT(j)  (256  + 64 * (j))
#define XB_XSUB(j)  (1280 + 64 * (j))
#define XB_XGEN(j)  (2304 + 64 * (j))
#define XB_TOP      3328
#define XB_TOPGEN   3392
#define XCD_BAR_WORDS 3456
#define XB_SPIN_CAP (1u << 18)

__device__ __forceinline__ unsigned xb_ld(unsigned* p)              { return __hip_atomic_load(p, __ATOMIC_RELAXED, __HIP_MEMORY_SCOPE_AGENT); }
__device__ __forceinline__ unsigned xb_add(unsigned* p, unsigned v) { return __hip_atomic_fetch_add(p, v, __ATOMIC_RELAXED, __HIP_MEMORY_SCOPE_AGENT); }
__device__ __forceinline__ unsigned xb_xcc_id() { return (unsigned)__builtin_amdgcn_s_getreg((3 << 11) | 20) & 0xFu; }
#define XB_SPIN(cond, bar) do { unsigned _sp = 0; while (cond) { __builtin_amdgcn_s_sleep(1); \
    if ((++_sp & 255u) == 0u) { if (xb_ld(&(bar)[XB_TMO])) break; if (_sp > XB_SPIN_CAP) { atomicAdd(&(bar)[XB_TMO], 1u); break; } } } } while (0)

struct XcdBarrier {
    unsigned* bar; unsigned x;
    volatile LAS unsigned* st;
};

__device__ __forceinline__ XcdBarrier xcd_barrier_post(unsigned* bar, volatile LAS unsigned* st) {
    XcdBarrier b; b.bar = bar; b.x = xb_xcc_id(); b.st = st;
    if (threadIdx.x == 0) (void)xb_add(&bar[XB_XCNT(b.x)], 1u);
    return b;
}
__device__ __forceinline__ void xcd_barrier_complete(unsigned* bar, unsigned x, unsigned& nloc, unsigned& nx) {
    const unsigned G = gridDim.x * gridDim.y * gridDim.z;
    unsigned sum, cnt, mine, sp = 0u;
    for (;;) {
        sum = 0u; cnt = 0u; mine = 0u;
#pragma unroll
        for (unsigned j = 0; j < 16; ++j) { const unsigned c = xb_ld(&bar[XB_XCNT(j)]); sum += c; cnt += (c > 0u) ? 1u : 0u; mine = (j == x) ? c : mine; }
        if (sum == G) break;
        __builtin_amdgcn_s_sleep(1);
        if ((++sp & 255u) == 0u) { if (xb_ld(&bar[XB_TMO])) break; if (sp > XB_SPIN_CAP) { atomicAdd(&bar[XB_TMO], 1u); break; } }
    }
    nloc = mine > 0u ? mine : 1u; nx = cnt > 0u ? cnt : 1u;
}

__device__ __forceinline__ void xcd_barrier(const XcdBarrier& b, bool leader  ) {
    asm volatile("s_waitcnt vmcnt(0)" ::: "memory");
    __syncthreads();
    if (leader) {
        unsigned* bar = b.bar;
        __builtin_amdgcn_s_waitcnt(0);
        unsigned nloc = b.st[0], nx = b.st[1];
        if (nloc == 0u) { xcd_barrier_complete(bar, b.x, nloc, nx); b.st[0] = nloc; b.st[1] = nx; }
        const unsigned old = xb_add(&bar[XB_XSUB(b.x)], 1u);
        const unsigned gen = old / nloc;
        if (old + 1u == (gen + 1u) * nloc) {
            __builtin_amdgcn_fence(__ATOMIC_RELEASE, "agent");
            asm volatile("s_waitcnt vmcnt(0)" ::: "memory");
            const unsigned og = xb_add(&bar[XB_TOP], 1u);
            const unsigned tg = og / nx;
            if (og + 1u == (tg + 1u) * nx) xb_add(&bar[XB_TOPGEN], 1u);
            else XB_SPIN(xb_ld(&bar[XB_TOPGEN]) == tg, bar);
            __builtin_amdgcn_fence(__ATOMIC_ACQUIRE, "agent");
            xb_add(&bar[XB_XGEN(b.x)], 1u);
            asm volatile("s_waitcnt vmcnt(0)" ::: "memory");
        } else {
            XB_SPIN(xb_ld(&bar[XB_XGEN(b.x)]) == gen, bar);
            __builtin_amdgcn_fence(__ATOMIC_ACQUIRE, "agent");
            asm volatile("s_waitcnt vmcnt(0)" ::: "memory");
        }
    }
    __syncthreads();
}

constexpr int RT_OFF = 131072, RT_MAX_UNITS = 15;
__device__ __forceinline__ void fill_rstd(const Frame& F, const pg8::StaticOrder& S, const float* SSQ) {
    LAS float* rt = (LAS float*)(F.lds + RT_OFF); pg8::Unit u;
    for (int i = 0; i < RT_MAX_UNITS && S.next(i, u); ++i) { const int rl = F.tid >> 1, hf = F.tid & 1;
        const f32x4* p = (const f32x4*)(SSQ + (size_t)(u.pm * 256 + rl) * 16 + 8 * hf); const f32x4 a = p[0], b = p[1];
        float s = ((a[0] + a[1]) + (a[2] + a[3])) + ((b[0] + b[1]) + (b[2] + b[3])); s += __shfl_xor(s, 1);
        if (hf == 0) rt[i * 256 + rl] = __builtin_amdgcn_rsqf(s * (1.0f / 1024.0f) + EPS); }
    __syncthreads();
}
__global__ void __launch_bounds__(NWAVES * 64, 2) fwd_mega(Args args) {
    extern __shared__ __attribute__((aligned(16))) unsigned char lds[];
    cg::grid_group grid = cg::this_grid();
    const Args& A = args;
    volatile LAS unsigned* xb_st = (volatile LAS unsigned*)((LAS unsigned char*)lds + LDS_BYTES - 64);
    if (threadIdx.x < 2) xb_st[threadIdx.x] = 0u;
    __syncthreads();
    const XcdBarrier xbar = xcd_barrier_post((unsigned*)(args.ws + WS_CTL + 65536), xb_st);
    for (int pi = args.ph_lo; pi < args.ph_hi; ++pi) {
        const int ph = PROG[pi];
        unsigned char* ws = args.ws; asm volatile("" : "+s"(ws));
        const float* SSQ = (const float*)(ws + WS_SSQ);
        int tid_ = threadIdx.x; asm volatile("" : "+v"(tid_));
        Frame F;
        F.lds = (LAS unsigned char*)lds; F.ws = ws;
        F.tid = tid_; F.lane = F.tid & 63; F.wave = __builtin_amdgcn_readfirstlane(F.tid >> 6);
        F.G = gridDim.x; F.gw = blockIdx.x * NWAVES + F.wave; F.NGW = F.G * NWAVES;
        if (ph == 0) { p0_prologue(F, A); }
        else {
            const int layer = (ph - 1) >> 3, sub = (ph - 1) & 7;
            unsigned char* wl = ws + WS_W + (size_t)layer * WL_STRIDE;
            const int bx = (int)blockIdx.x;
            if (sub == 0) {
                pg8::Gemm g{(const bf16*)(ws + WS_R0), (const bf16*)(wl + WL_QKV), M, NQKV, 1024}; pg8::StaticOrder S; S.init(M, NQKV, F.G, bx);
                p1_forget(F, A, layer);
                fill_rstd(F, S, SSQ);
                pg8::EpiQKV E{(const LAS float*)(F.lds + RT_OFF), ws, (const float*)(ws + WS_GAIN) + layer * 256, C2};
                pg8::gemm_phase<pg8::EpiQKV, pg8::StaticOrder, true, true>(F.lds, g, S, E);
            } else if (sub == 1) {
            } else if (sub == 2) { p3_attention(F, A, layer);
            } else if (sub == 3) {
                p4_combine(F);
            } else if (sub == 4) {
                pg8::StaticOrder S; S.init(M, 1024, F.G, bx);
                fill_rstd(F, S, SSQ);
#pragma unroll 1
                for (int br = 0; br < 3; ++br) {
                    { pg8::Gemm g{(const bf16*)(ws + WS_R0), (const bf16*)(wl + WL_G) + (size_t)br * 1024 * 1024, M, 1024, 1024};
                      pg8::EpiAct<0> E{(const LAS float*)(F.lds + RT_OFF), (bf16*)(ws + WS_GATE), 1024};
                      pg8::gemm_phase<pg8::EpiAct<0>, pg8::StaticOrder, true, true>(F.lds, g, S, E); }
                    { const bf16* Ab = (const bf16*)(ws + (br == 0 ? WS_FOXQ : br == 1 ? WS_SBQ : WS_OC)); const bf16* Bb = (const bf16*)(wl + (br == 0 ? WL_A : br == 1 ? WL_B : WL_C));
                      pg8::Gemm g{Ab, Bb, M, 1024, br == 2 ? 256 : 512}; pg8::EpiMerge E{(const bf16*)(ws + WS_GATE), (bf16*)(ws + WS_MRG), br};
                      pg8::gemm_phase<pg8::EpiMerge, pg8::StaticOrder, true, true>(F.lds, g, S, E); }
                }
            } else if (sub == 5) {
                pg8::Gemm g{(const bf16*)(ws + WS_MRG), (const bf16*)(wl + WL_O), M, 1024, 1024}; pg8::StaticOrder S; S.init(M, 1024, F.G, bx);
                pg8::EpiRes E{layer == 0 ? IN_X(A) : A.out, A.out, (bf16*)(ws + WS_R1), IN_MLP_NORM(A) + layer * 1024, (float*)(ws + WS_SSQ)};
                pg8::gemm_phase<pg8::EpiRes, pg8::StaticOrder, true, true>(F.lds, g, S, E);
            } else if (sub == 6) {
                pg8::Gemm g{(const bf16*)(ws + WS_R1), (const bf16*)(wl + WL_MI), M, DFF, 1024}; pg8::StaticOrder S; S.init(M, DFF, F.G, bx);
                fill_rstd(F, S, SSQ);
                pg8::EpiAct<1> E{(const LAS float*)(F.lds + RT_OFF), (bf16*)(ws + WS_HID), DFF};
                pg8::gemm_phase<pg8::EpiAct<1>, pg8::StaticOrder, true, true>(F.lds, g, S, E);
            } else {
                pg8::Gemm g{(const bf16*)(ws + WS_HID), (const bf16*)(wl + WL_MO), M, 1024, DFF}; pg8::StaticOrder S; S.init(M, 1024, F.G, bx);
                const bool last = layer == DEPTH - 1;
                pg8::EpiRes E{A.out, A.out, last ? (bf16*)nullptr : (bf16*)(ws + WS_R0), IN_ATTN_NORM(A) + (last ? 0 : (layer + 1) * 1024), (float*)(ws + WS_SSQ)};
                pg8::gemm_phase<pg8::EpiRes, pg8::StaticOrder, true, true>(F.lds, g, S, E);
            }
        }
        if (pi + 1 < args.ph_hi) {
            if (args.ph_hi > 4096) {
                asm volatile("s_waitcnt vmcnt(0) lgkmcnt(0)" ::: "memory");
                grid.sync();
                __builtin_amdgcn_fence(__ATOMIC_ACQUIRE, "agent");
                asm volatile("s_waitcnt vmcnt(0)" ::: "memory");
            } else xcd_barrier(xbar, F.tid == 0);
        }
    }
}


#ifndef N_LAUNCH_MODE
#define N_LAUNCH_MODE 1
#endif
extern "C" void kernel_launch(void* const* d_in, const int* in_sizes, int n_in, void* d_out, int out_size, void* d_ws, size_t ws_size, hipStream_t stream) {
    static int grid = 0;
    if (grid == 0) {
        if (n_in != 16 || out_size != M * DMODEL || ws_size < WS_END) { fprintf(stderr, "kernel_launch: unexpected shapes (n_in %d out %d ws %zu)\n", n_in, out_size, ws_size); grid = -1; return; }
        int dev = 0, cus = 0, per_cu = 0;
        hipGetDevice(&dev); hipDeviceGetAttribute(&cus, hipDeviceAttributeMultiprocessorCount, dev);
        hipFuncSetAttribute((const void*)fwd_mega, hipFuncAttributeMaxDynamicSharedMemorySize, LDS_BYTES);
        hipOccupancyMaxActiveBlocksPerMultiprocessor(&per_cu, (const void*)fwd_mega, NWAVES * 64, LDS_BYTES);
        if (per_cu < 1) per_cu = 1;
        grid = cus * per_cu;
        (void)hipGetLastError();
    }
    if (grid < 0) return;
    if (hipMemsetAsync((unsigned char*)d_ws + WS_CTL, 0, 131072, stream) != hipSuccess) { fprintf(stderr, "kernel_launch: memset of the control words failed\n"); return; }
    Args a{};
    for (int i = 0; i < 16; ++i) a.in[i] = d_in[i];
    a.out = (float*)d_out; a.ws = (unsigned char*)d_ws;
#if N_LAUNCH_MODE == 1
    a.ph_lo = 0; a.ph_hi = NPROG;
    { void* kargs[] = {&a}; hipError_t e = hipLaunchCooperativeKernel((const void*)fwd_mega, dim3(grid), dim3(NWAVES * 64), kargs, LDS_BYTES, stream);
      if (e != hipSuccess) fprintf(stderr, "cooperative launch failed: %s (grid %d)\n", hipGetErrorString(e), grid); }
#else
    const int nph = NPROG;
    for (int ph = 0; ph < nph; ++ph) { a.ph_lo = ph; a.ph_hi = ph + 1; void* kargs[] = {&a};
        hipError_t e = hipLaunchCooperativeKernel((const void*)fwd_mega, dim3(grid), dim3(NWAVES * 64), kargs, LDS_BYTES, stream);
        if (e != hipSuccess) { fprintf(stderr, "launch %d failed: %s\n", ph, hipGetErrorString(e)); break; } }
#endif
}
```

```cpp
#include <hip/hip_runtime.h>
#include <hip/hip_cooperative_groups.h>
#include <cstdio>
#include <cstdint>
#include <cmath>
namespace cg = cooperative_groups;
constexpr int NWAVES = 8;
constexpr int BATCH = 16, SEQ = 2048, DMODEL = 1024, DEPTH = 2, M = BATCH * SEQ, DIN = 8456, DFF = 4096;
constexpr int NQKV = 5376, NGATE = 3072;
constexpr float EPS = 1e-6f, LOG2E = 1.4426950408889634f, C2 = 0.125f * 1.4426950408889634f;
constexpr size_t KiB = 1024, MiB = 1u << 20;
constexpr size_t WL_QKV = 0, WL_G = 10752 * KiB, WL_A = 16896 * KiB, WL_B = 17920 * KiB, WL_C = 18944 * KiB, WL_O = 19456 * KiB, WL_MI = 21504 * KiB, WL_MO = 29696 * KiB, WL_STRIDE = 38 * MiB;
constexpr size_t WS_W = 0, WS_CTL = 76 * MiB, WS_SSQ = 77 * MiB, WS_LFS = 79 * MiB, WS_LSE = 80 * MiB, WS_CTOT = 81 * MiB + 512 * KiB;
constexpr size_t WS_R0 = 82 * MiB, WS_FOXQ = 146 * MiB, WS_SBQ = 178 * MiB, WS_DILQ = 210 * MiB;
constexpr size_t WS_FOXK = 258 * MiB, WS_FOXV = 290 * MiB, WS_SBK = 322 * MiB, WS_SBV = 354 * MiB, WS_DILK = 386 * MiB, WS_DILV = 434 * MiB;
constexpr size_t WS_GAIN = 81 * MiB + 768 * KiB;
constexpr size_t WS_COS = 498 * MiB, WS_SIN = 502 * MiB;
constexpr size_t WS_GATE = 258 * MiB  , WS_MRG = 322 * MiB  , WS_OC = 482 * MiB, WS_R1 = 146 * MiB, WS_HID = 210 * MiB, WS_END = 506 * MiB;
constexpr int LDS_BYTES = 147456;
constexpr int NPHASE = 1 + 8 * DEPTH;
constexpr int ITEMS_PER_LAYER = 9472;
constexpr int N_ATT_UNITS = 64 * 256 + 16 * 12 * 64;

static_assert(WS_FOXQ == 146 * MiB && WS_SBQ == 178 * MiB && WS_DILQ == 210 * MiB && WS_FOXK == 258 * MiB && WS_SBK == 322 * MiB && WS_DILK == 386 * MiB && WS_FOXV == 290 * MiB && WS_SBV == 354 * MiB && WS_DILV == 434 * MiB, "EpiQKV plane offsets");
static_assert(WS_FOXQ == 146 * MiB && WS_SBQ == 178 * MiB && WS_DILQ == 210 * MiB && WS_FOXK == 258 * MiB && WS_SBK == 322 * MiB && WS_DILK == 386 * MiB && WS_FOXV == 290 * MiB && WS_SBV == 354 * MiB && WS_DILV == 434 * MiB, "EpiQKV plane offsets");
namespace pg8 {
#define PG8_LAS __attribute__((address_space(3)))
typedef unsigned short bf16_t;
typedef short bf16x8 __attribute__((ext_vector_type(8)));
typedef float f32x4 __attribute__((ext_vector_type(4)));
typedef unsigned u32x4 __attribute__((ext_vector_type(4)));
constexpr int BM = 256, BK = 64, HALF = 128, HTB = HALF * BK * 2  , STAGE_BYTES = 8 * HTB, NXCD = 8, WGM = 8;

__host__ __device__ __forceinline__ int lds_byte(int r, int c) { const int st = (r >> 4) * 2 + (c >> 5), rr = r & 15, cc = c & 31, ob = rr * 64 + cc * 2; return st * 1024 + (ob ^ (((ob >> 9) & 1) << 5)); }
__host__ __device__ __forceinline__ void stage_rc(int b, int& R, int& C) { const int st = b / 1024, sb = b % 1024, swz = sb ^ (((sb >> 9) & 1) << 5); R = (st >> 1) * 16 + swz / 64; C = (st & 1) * 32 + (swz % 64) / 2; }
__host__ __device__ __forceinline__ int perm32(int rho) { const int n = rho >> 4, i = rho & 15; return 8 * (i >> 2) + 4 * n + (i & 3); }

struct Unit { int pm, pn, idx; };
struct Gemm { const bf16_t* A; const bf16_t* Bt; int M, N, K; };

struct StaticOrder {
    int nM, nN, nwg, G, c;
    __host__ __device__ void init(int M, int N, int G_, int c_) { nM = M / BM; nN = N / BM; nwg = nM * nN; G = G_; c = c_; }
    __host__ __device__ bool next(int i, Unit& u) const {
        const long L = (long)i * G + c; if (L >= nwg) return false;
        int wgid = (int)L; { const int q = nwg / NXCD, r = nwg % NXCD, xcd = wgid % NXCD, off = wgid / NXCD; wgid = (xcd < r ? xcd * (q + 1) : r * (q + 1) + (xcd - r) * q) + off; }
        const int nig = WGM * nN, gid = wgid / nig, fm = gid * WGM, gsz = (nM - fm) < WGM ? (nM - fm) : WGM;
        u.pm = fm + ((wgid % nig) % gsz); u.pn = (wgid % nig) / gsz; u.idx = i; return true;
    }
    __device__ __forceinline__ void a_ready(const Unit&) const {}
    __device__ __forceinline__ void done(const Unit&) const {}
};

typedef float f32x2c_t __attribute__((ext_vector_type(2))); typedef __bf16 bf16x2c_t __attribute__((ext_vector_type(2)));
__device__ __forceinline__ unsigned cvt_pk_bf16(float lo, float hi) { f32x2c_t v = {lo, hi}; bf16x2c_t b = __builtin_convertvector(v, bf16x2c_t); return __builtin_bit_cast(unsigned, b); }
typedef float f32x2 __attribute__((ext_vector_type(2)));
typedef unsigned u32x2 __attribute__((ext_vector_type(2)));
constexpr float RMS_EPS = 1e-6f;
__device__ __forceinline__ float row_rstd(const float* ssq, int row) {
    const f32x4* p = (const f32x4*)(ssq + (size_t)row * 16);
    const f32x4 a = p[0], b = p[1], c = p[2], d = p[3];
    const float s = (((a[0] + a[1]) + (a[2] + a[3])) + ((b[0] + b[1]) + (b[2] + b[3]))) + (((c[0] + c[1]) + (c[2] + c[3])) + ((d[0] + d[1]) + (d[2] + d[3])));
    return __builtin_amdgcn_rsqf(s * (1.0f / 1024.0f) + RMS_EPS);
}
__device__ __forceinline__ float bf2f(unsigned short v) { return __uint_as_float((unsigned)v << 16); }
__device__ __forceinline__ float bflo(unsigned w) { return __uint_as_float(w << 16); }
__device__ __forceinline__ float bfhi(unsigned w) { return __uint_as_float(w & 0xffff0000u); }

struct EpiQKV {
    static constexpr bool PERM = true, AFTER_DRAIN = false;
    const PG8_LAS float* rt;
    unsigned char* __restrict__ ws;
    const float* __restrict__ gains;
    float c2;
    __device__ __forceinline__ void operator()(const f32x4 (&acc)[2][2][4][2], const Unit& u, int wr, int wc, int fr, int fq) const {
        const int pn = u.pn;
        int kind, plane, ct;
        if (pn < 6) { kind = 0; plane = pn >> 1; ct = pn & 1; } else if (pn < 12) { kind = 1; plane = (pn - 6) >> 1; ct = (pn - 6) & 1; } else { kind = 2; plane = (pn - 12) / 3; ct = (pn - 12) % 3; }
        const int pitch = kind == 2 ? 768 : 512, H = kind == 2 ? 12 : 8;
        const size_t pofs = (plane == 0 ? (size_t)(146 + 32 * kind) : (size_t)(258 + 64 * kind + (plane == 2 ? (kind == 2 ? 48 : 32) : 0))) << 20;
        bf16_t* P = (bf16_t*)(ws + pofs);
        const int row0 = u.pm * BM + wr * 64 + fr;
        const int lg = (kind == 2 && plane > 0) ? 2 * ct : 0;
        const int b = (u.pm * BM) >> 11, t0 = ((u.pm * BM) & 2047) + wr * 64 + fr;
        if (plane < 2) {
            const int hh = 4 * ct + wc; const bool normed = kind != 1, rot = kind == 2;
            f32x4 gv[2][2];
            { const float* gp = gains + ((kind == 2 ? 2 : 0) + plane) * 64; const float gs = plane == 0 ? c2 : 1.0f;
#pragma unroll
              for (int bj = 0; bj < 2; ++bj)
#pragma unroll
                  for (int n = 0; n < 2; ++n) gv[bj][n] = normed ? *(const f32x4*)(gp + 32 * bj + 8 * fq + 4 * n) * gs : (f32x4){1.f, 1.f, 1.f, 1.f}; }
            const float* COS = (const float*)(ws + WS_COS); const float* SIN = (const float*)(ws + WS_SIN);
#pragma unroll
            for (int ai = 0; ai < 2; ++ai)
#pragma unroll
                for (int m = 0; m < 4; ++m) { const int row = row0 + ai * HALF + m * 16; const float r = rt[u.idx * 256 + ai * HALF + wr * 64 + m * 16 + fr];
                    f32x4 v[2][2];
#pragma unroll
                    for (int bj = 0; bj < 2; ++bj)
#pragma unroll
                        for (int n = 0; n < 2; ++n) v[bj][n] = acc[ai][bj][m][n] * r;
                    if (normed) { float ss = 0.f;
#pragma unroll
                        for (int bj = 0; bj < 2; ++bj)
#pragma unroll
                            for (int n = 0; n < 2; ++n) ss += (v[bj][n][0] * v[bj][n][0] + v[bj][n][1] * v[bj][n][1]) + (v[bj][n][2] * v[bj][n][2] + v[bj][n][3] * v[bj][n][3]);
                        ss += __shfl_xor(ss, 16); ss += __shfl_xor(ss, 32);
                        const float rn = __builtin_amdgcn_rsqf(ss * (1.0f / 64.0f) + RMS_EPS);
#pragma unroll
                        for (int bj = 0; bj < 2; ++bj)
#pragma unroll
                            for (int n = 0; n < 2; ++n) v[bj][n] = v[bj][n] * rn * gv[bj][n]; }
                    if (rot) {
#pragma unroll
                        for (int n = 0; n < 2; ++n) { const f32x4 cs = *(const f32x4*)(COS + (size_t)row * 32 + 8 * fq + 4 * n), sn = *(const f32x4*)(SIN + (size_t)row * 32 + 8 * fq + 4 * n);
                            const f32x4 x1 = v[0][n], x2 = v[1][n]; v[0][n] = x1 * cs - x2 * sn; v[1][n] = x2 * cs + x1 * sn; } }
                    bf16_t* dst;
                    if (plane == 0) dst = P + (size_t)row * pitch + hh * 64 + 8 * fq;
                    else { const int t = t0 + ai * HALF + m * 16; const int tpos = ((t & ((1 << lg) - 1)) << (11 - lg)) + (t >> lg); dst = P + ((size_t)(b * H + hh) * 2048 + tpos) * 64 + 8 * fq; }
#pragma unroll
                    for (int bj = 0; bj < 2; ++bj) { u32x4 w; w.x = cvt_pk_bf16(v[bj][0][0], v[bj][0][1]); w.y = cvt_pk_bf16(v[bj][0][2], v[bj][0][3]); w.z = cvt_pk_bf16(v[bj][1][0], v[bj][1][1]); w.w = cvt_pk_bf16(v[bj][1][2], v[bj][1][3]);
                        *(u32x4*)(dst + 32 * bj) = w; } }
        } else {
#pragma unroll
            for (int ai = 0; ai < 2; ++ai)
#pragma unroll
                for (int m = 0; m < 4; ++m) { const int t = t0 + ai * HALF + m * 16; const int tpos = ((t & ((1 << lg) - 1)) << (11 - lg)) + (t >> lg); const float r = rt[u.idx * 256 + ai * HALF + wr * 64 + m * 16 + fr];
#pragma unroll
                    for (int bj = 0; bj < 2; ++bj) { const int colb = ct * 256 + bj * HALF + wc * 32 + 8 * fq; const int hh = colb >> 6, d0 = colb & 63;
                        bf16_t* vp = P + (((size_t)(b * H + hh) * 64 + (tpos >> 5)) * 64 + d0) * 32 + (tpos & 31);
#pragma unroll
                        for (int n = 0; n < 2; ++n) { const f32x4 v = acc[ai][bj][m][n] * r; const unsigned w0 = cvt_pk_bf16(v[0], v[1]), w1 = cvt_pk_bf16(v[2], v[3]);
                            vp[(4 * n + 0) * 32] = (bf16_t)(w0 & 0xffffu); vp[(4 * n + 1) * 32] = (bf16_t)(w0 >> 16);
                            vp[(4 * n + 2) * 32] = (bf16_t)(w1 & 0xffffu); vp[(4 * n + 3) * 32] = (bf16_t)(w1 >> 16); } } }
        }
    }
};
template <int ACT> struct EpiAct {
    static constexpr bool PERM = true, AFTER_DRAIN = false;
    const PG8_LAS float* rt; bf16_t* __restrict__ O; int ldc;
    __device__ __forceinline__ float act(float x) const { if (ACT == 0) return __builtin_amdgcn_rcpf(1.0f + __builtin_amdgcn_exp2f(-1.4426950408889634f * x)); const float y = fmaxf(x, 0.f); return y * y; }
    __device__ __forceinline__ void operator()(const f32x4 (&acc)[2][2][4][2], const Unit& u, int wr, int wc, int fr, int fq) const {
        const int row0 = u.pm * BM + wr * 64 + fr, col0 = u.pn * BM + wc * 32 + 8 * fq;
#pragma unroll
        for (int ai = 0; ai < 2; ++ai)
#pragma unroll
            for (int m = 0; m < 4; ++m) { const int row = row0 + ai * HALF + m * 16; const float r = rt[u.idx * 256 + ai * HALF + wr * 64 + m * 16 + fr]; bf16_t* rowp = O + (size_t)row * ldc + col0;
#pragma unroll
                for (int bj = 0; bj < 2; ++bj) { const f32x4 v0 = acc[ai][bj][m][0] * r, v1 = acc[ai][bj][m][1] * r;
                    u32x4 w; w.x = cvt_pk_bf16(act(v0[0]), act(v0[1])); w.y = cvt_pk_bf16(act(v0[2]), act(v0[3])); w.z = cvt_pk_bf16(act(v1[0]), act(v1[1])); w.w = cvt_pk_bf16(act(v1[2]), act(v1[3]));
                    *(u32x4*)(rowp + bj * HALF) = w; } }
    }
};
struct EpiMerge {
    static constexpr bool PERM = true, AFTER_DRAIN = false;
    const bf16_t* __restrict__ G; bf16_t* __restrict__ O; int BR;
    __device__ __forceinline__ void operator()(const f32x4 (&acc)[2][2][4][2], const Unit& u, int wr, int wc, int fr, int fq) const {
        const int row0 = u.pm * BM + wr * 64 + fr, col0 = u.pn * BM + wc * 32 + 8 * fq;
#pragma unroll
        for (int ai = 0; ai < 2; ++ai) {
#pragma unroll
            for (int mp = 0; mp < 2; ++mp) {
                u32x4 g[2][2], p[2][2];
#pragma unroll
                for (int mm = 0; mm < 2; ++mm)
#pragma unroll
                    for (int bj = 0; bj < 2; ++bj) g[mm][bj] = *(const u32x4*)(G + (size_t)(row0 + ai * HALF + (2 * mp + mm) * 16) * 1024 + col0 + bj * HALF);
                if (BR > 0) {
#pragma unroll
                    for (int mm = 0; mm < 2; ++mm)
#pragma unroll
                        for (int bj = 0; bj < 2; ++bj) p[mm][bj] = *(const u32x4*)(O + (size_t)(row0 + ai * HALF + (2 * mp + mm) * 16) * 1024 + col0 + bj * HALF);
                } else {
#pragma unroll
                    for (int mm = 0; mm < 2; ++mm)
#pragma unroll
                        for (int bj = 0; bj < 2; ++bj) p[mm][bj] = (u32x4){0u, 0u, 0u, 0u};
                }
#pragma unroll
                for (int mm = 0; mm < 2; ++mm)
#pragma unroll
                    for (int bj = 0; bj < 2; ++bj) { const int m = 2 * mp + mm; const u32x4 gg = g[mm][bj], pp = p[mm][bj]; const f32x4 a0 = acc[ai][bj][m][0], a1 = acc[ai][bj][m][1];
                        const float o0 = a0[0] * bflo(gg.x) + bflo(pp.x), o1 = a0[1] * bfhi(gg.x) + bfhi(pp.x), o2 = a0[2] * bflo(gg.y) + bflo(pp.y), o3 = a0[3] * bfhi(gg.y) + bfhi(pp.y);
                        const float o4 = a1[0] * bflo(gg.z) + bflo(pp.z), o5 = a1[1] * bfhi(gg.z) + bfhi(pp.z), o6 = a1[2] * bflo(gg.w) + bflo(pp.w), o7 = a1[3] * bfhi(gg.w) + bfhi(pp.w);
                        u32x4 w; w.x = cvt_pk_bf16(o0, o1); w.y = cvt_pk_bf16(o2, o3); w.z = cvt_pk_bf16(o4, o5); w.w = cvt_pk_bf16(o6, o7);
                        *(u32x4*)(O + (size_t)(row0 + ai * HALF + m * 16) * 1024 + col0 + bj * HALF) = w; }
            }
        }
    }
};
struct EpiRes {
    static constexpr bool PERM = false, AFTER_DRAIN = false;
    const float* __restrict__ xin; float* __restrict__ xout; bf16_t* __restrict__ xn; const float* __restrict__ gain; float* __restrict__ ssq;
    __device__ __forceinline__ void operator()(const f32x4 (&acc)[2][2][4][2], const Unit& u, int wr, int wc, int fr, int fq) const {
        const int col0 = u.pn * BM + wc * 32 + 4 * fq; const bool nx = xn != nullptr;
        f32x4 gv[2][2];
#pragma unroll
        for (int bj = 0; bj < 2; ++bj)
#pragma unroll
            for (int n = 0; n < 2; ++n) gv[bj][n] = nx ? *(const f32x4*)(gain + col0 + bj * HALF + n * 16) : (f32x4){0.f, 0.f, 0.f, 0.f};
#pragma unroll
        for (int ai = 0; ai < 2; ++ai)
#pragma unroll
            for (int mp = 0; mp < 2; ++mp) {
                f32x4 xi[2][2][2];
#pragma unroll
                for (int mm = 0; mm < 2; ++mm) { const size_t off = (size_t)(u.pm * BM + ai * HALF + wr * 64 + (2 * mp + mm) * 16 + fr) * 1024 + col0;
#pragma unroll
                    for (int bj = 0; bj < 2; ++bj)
#pragma unroll
                        for (int n = 0; n < 2; ++n) xi[mm][bj][n] = *(const f32x4*)(xin + off + bj * HALF + n * 16); }
#pragma unroll
                for (int mm = 0; mm < 2; ++mm) { const int m = 2 * mp + mm; const int row = u.pm * BM + ai * HALF + wr * 64 + m * 16 + fr; const size_t off = (size_t)row * 1024 + col0; float s = 0.f;
#pragma unroll
                    for (int bj = 0; bj < 2; ++bj)
#pragma unroll
                        for (int n = 0; n < 2; ++n) { const f32x4 o = xi[mm][bj][n] + acc[ai][bj][m][n];
                            *(f32x4*)(xout + off + bj * HALF + n * 16) = o;
                            if (nx) { s += (o[0] * o[0] + o[1] * o[1]) + (o[2] * o[2] + o[3] * o[3]); const f32x4 y = o * gv[bj][n]; u32x2 w; w.x = cvt_pk_bf16(y[0], y[1]); w.y = cvt_pk_bf16(y[2], y[3]);
                                *(u32x2*)(xn + off + bj * HALF + n * 16) = w; } }
                    if (nx) { s += __shfl_xor(s, 16); s += __shfl_xor(s, 32); if (fq == 0) ssq[(size_t)row * 16 + u.pn * 4 + wc] = s; } }
            }
    }
};
template <class Epi, class Sched, bool ALIGN_EPI = false, bool SP2 = false>
__device__ __forceinline__ void gemm_phase(PG8_LAS unsigned char* lds, const Gemm g, const Sched& S, const Epi& E) {
    int tid_ = threadIdx.x; asm volatile("" : "+v"(tid_));
    const int tid = tid_, wid = __builtin_amdgcn_readfirstlane(tid >> 6), lane = tid & 63, wr = wid >> 2, wc = wid & 3, fr = lane & 15, fq = lane >> 4;
    const int K = g.K, nt = K / BK;
    unsigned voffA[2], voffB[2];
#pragma unroll
    for (int i = 0; i < 2; ++i) { int R, C; stage_rc(tid * 16 + i * 8192, R, C); const int Rb = Epi::PERM ? ((R & ~31) + perm32(R & 31)) : R;
        voffA[i] = (unsigned)(R * K + C) * 2u; voffB[i] = (unsigned)(Rb * K + C) * 2u; }
    const size_t kstep = (size_t)(BK * 2);
    const size_t hstep = (size_t)HALF * K * 2;
    const size_t tstep = 2 * hstep;
    const unsigned ldsw = (unsigned)wid * 1024u;
    const int aoff = lds_byte(wr * 64 + fr, fq * 8), boff = lds_byte(wc * 32 + fr, fq * 8);
#define PG8_SA(b, h) (((b) * 2 + (h)) * HTB)
#define PG8_SB(b, h) ((4 + (b) * 2 + (h)) * HTB)
#define PG8_STAGE(bufoff, gbase, voff) do { _Pragma("unroll") for (int _i = 0; _i < 2; ++_i) \
        __builtin_amdgcn_global_load_lds((const unsigned*)((const char*)(gbase) + (voff)[_i]), (PG8_LAS unsigned*)(lds + (bufoff) + ldsw + _i * 8192), 16, 0, 0); } while (0)
#define PG8_LDA(dst, b, h) do { _Pragma("unroll") for (int m = 0; m < 4; ++m) _Pragma("unroll") for (int k = 0; k < 2; ++k) dst[m][k] = *(const PG8_LAS bf16x8*)(lds + PG8_SA(b, h) + aoff + m * 2048 + k * 1024); } while (0)
#define PG8_LDB(dst, b, h) do { _Pragma("unroll") for (int n = 0; n < 2; ++n) _Pragma("unroll") for (int k = 0; k < 2; ++k) dst[n][k] = *(const PG8_LAS bf16x8*)(lds + PG8_SB(b, h) + boff + n * 2048 + k * 1024); } while (0)
#define PG8_MMA(ai, bj, At, Bt) do { __builtin_amdgcn_s_setprio(1); _Pragma("unroll") for (int m = 0; m < 4; ++m) _Pragma("unroll") for (int n = 0; n < 2; ++n) _Pragma("unroll") for (int k = 0; k < 2; ++k) \
        acc[ai][bj][m][n] = __builtin_amdgcn_mfma_f32_16x16x32_bf16(Bt[n][k], At[m][k], acc[ai][bj][m][n], 0, 0, 0); __builtin_amdgcn_s_setprio(0); } while (0)
#define PG8_WAIT_V(n) asm volatile("s_waitcnt vmcnt(" #n ")" ::: "memory")
#define PG8_WAIT_L(n) asm volatile("s_waitcnt lgkmcnt(" #n ")" ::: "memory")
#define PG8_BAR __builtin_amdgcn_s_barrier()
#define PG8_SCHED __builtin_amdgcn_sched_barrier(0)
    Unit cur, nxt; int ui = 0;
    if (!S.next(0, cur)) return;
    f32x4 acc[2][2][4][2];
#pragma unroll
    for (int a = 0; a < 2; ++a)
#pragma unroll
        for (int b = 0; b < 2; ++b)
#pragma unroll
            for (int m = 0; m < 4; ++m)
#pragma unroll
                for (int n = 0; n < 2; ++n) acc[a][b][m][n] = (f32x4){0.f, 0.f, 0.f, 0.f};
    bf16x8 At[4][2], B0[2][2], B1[2][2];
    const char* cA = (const char*)g.A + (size_t)cur.pm * tstep; const char* cB = (const char*)g.Bt + (size_t)cur.pn * tstep;
    S.a_ready(cur);
    if constexpr (SP2) {
        PG8_STAGE(PG8_SB(0, 0), cB, voffB); PG8_STAGE(PG8_SB(0, 1), cB + hstep, voffB); PG8_STAGE(PG8_SA(0, 0), cA, voffA); PG8_STAGE(PG8_SA(0, 1), cA + hstep, voffA);
        if (wr == 1) PG8_BAR;
        PG8_WAIT_V(2); PG8_BAR;
        PG8_STAGE(PG8_SB(1, 0), cB + kstep, voffB); PG8_STAGE(PG8_SA(1, 0), cA + kstep, voffA); PG8_STAGE(PG8_SB(1, 1), cB + hstep + kstep, voffB);
        PG8_WAIT_V(6); PG8_BAR;
    } else {
        PG8_STAGE(PG8_SB(0, 0), cB, voffB); PG8_STAGE(PG8_SA(0, 0), cA, voffA); PG8_STAGE(PG8_SB(0, 1), cB + hstep, voffB); PG8_STAGE(PG8_SA(0, 1), cA + hstep, voffA);
        if (wr == 1) PG8_BAR;
        PG8_WAIT_V(4); PG8_BAR;
        PG8_STAGE(PG8_SB(1, 0), cB + kstep, voffB); PG8_STAGE(PG8_SA(1, 0), cA + kstep, voffA); PG8_STAGE(PG8_SB(1, 1), cB + hstep + kstep, voffB);
        PG8_WAIT_V(6); PG8_BAR;
    }
    for (;;) {
        const bool has_next = S.next(ui + 1, nxt);
        const char* nA = has_next ? (const char*)g.A + (size_t)nxt.pm * tstep : cA; const char* nB = has_next ? (const char*)g.Bt + (size_t)nxt.pn * tstep : cB;
        for (int t = 0; t < nt; t += 2) {
            const bool last = (t == nt - 2);
            const char* a1 = cA + (size_t)(t + 1) * kstep;
            const char* a2 = last ? nA : cA + (size_t)(t + 2) * kstep; const char* b2 = last ? nB : cB + (size_t)(t + 2) * kstep;
            const char* a3 = a2 + kstep; const char* b3 = b2 + kstep;
            if (last && has_next) S.a_ready(nxt);
            if constexpr (SP2) {
            PG8_LDB(B0, 0, 0); PG8_LDB(B1, 0, 1); PG8_SCHED; PG8_LDA(At, 0, 0); PG8_STAGE(PG8_SA(1, 1), a1 + hstep, voffA);
            PG8_WAIT_V(8); PG8_WAIT_L(0); PG8_BAR; PG8_MMA(0, 0, At, B0); PG8_MMA(0, 1, At, B1); PG8_BAR; PG8_SCHED;
            PG8_LDA(At, 0, 1); PG8_STAGE(PG8_SB(0, 0), b2, voffB); PG8_STAGE(PG8_SB(0, 1), b2 + hstep, voffB); PG8_STAGE(PG8_SA(0, 0), a2, voffA);
            PG8_WAIT_V(8); PG8_WAIT_L(0); PG8_BAR; PG8_MMA(1, 0, At, B0); PG8_MMA(1, 1, At, B1); PG8_BAR; PG8_SCHED;
            PG8_LDB(B0, 1, 0); PG8_LDB(B1, 1, 1); PG8_SCHED; PG8_LDA(At, 1, 0); PG8_STAGE(PG8_SA(0, 1), a2 + hstep, voffA);
            PG8_WAIT_V(8); PG8_WAIT_L(0); PG8_BAR; PG8_MMA(0, 0, At, B0); PG8_MMA(0, 1, At, B1); PG8_BAR; PG8_SCHED;
            PG8_LDA(At, 1, 1); PG8_STAGE(PG8_SB(1, 0), b3, voffB); PG8_STAGE(PG8_SB(1, 1), b3 + hstep, voffB); PG8_STAGE(PG8_SA(1, 0), a3, voffA);
            PG8_WAIT_V(8); PG8_WAIT_L(0); PG8_BAR; PG8_MMA(1, 0, At, B0); PG8_MMA(1, 1, At, B1); PG8_BAR; PG8_SCHED;
            } else {
            PG8_LDB(B0, 0, 0); PG8_SCHED; PG8_LDA(At, 0, 0); PG8_STAGE(PG8_SA(1, 1), a1 + hstep, voffA);
            PG8_WAIT_L(8); PG8_BAR; PG8_WAIT_L(0); PG8_MMA(0, 0, At, B0); PG8_BAR; PG8_SCHED;
            PG8_LDB(B1, 0, 1); PG8_STAGE(PG8_SB(0, 0), b2, voffB);
            PG8_BAR; PG8_WAIT_L(0); PG8_MMA(0, 1, At, B1); PG8_BAR;
            PG8_LDA(At, 0, 1); PG8_STAGE(PG8_SA(0, 0), a2, voffA);
            PG8_BAR; PG8_WAIT_L(0); PG8_MMA(1, 0, At, B0); PG8_BAR; PG8_SCHED;
            PG8_STAGE(PG8_SB(0, 1), b2 + hstep, voffB);
            PG8_WAIT_V(6); PG8_BAR; PG8_MMA(1, 1, At, B1); PG8_BAR;
            PG8_LDB(B0, 1, 0); PG8_SCHED; PG8_LDA(At, 1, 0); PG8_STAGE(PG8_SA(0, 1), a2 + hstep, voffA);
            PG8_WAIT_L(8); PG8_BAR; PG8_WAIT_L(0); PG8_MMA(0, 0, At, B0); PG8_BAR; PG8_SCHED;
            PG8_LDB(B1, 1, 1); PG8_STAGE(PG8_SB(1, 0), b3, voffB);
            PG8_BAR; PG8_WAIT_L(0); PG8_MMA(0, 1, At, B1); PG8_BAR;
            PG8_LDA(At, 1, 1); PG8_STAGE(PG8_SA(1, 0), a3, voffA);
            PG8_BAR; PG8_WAIT_L(0); PG8_MMA(1, 0, At, B0); PG8_BAR; PG8_SCHED;
            PG8_STAGE(PG8_SB(1, 1), b3 + hstep, voffB);
            PG8_WAIT_V(6); PG8_BAR; PG8_MMA(1, 1, At, B1); PG8_BAR;
            }
        }
        if constexpr (ALIGN_EPI) { if (wr == 0) PG8_BAR; }
        if constexpr (!Epi::AFTER_DRAIN) { E(acc, cur, wr, wc, fr, fq); S.done(cur); }
        if (!has_next) break;
#pragma unroll
        for (int a = 0; a < 2; ++a)
#pragma unroll
            for (int b = 0; b < 2; ++b)
#pragma unroll
                for (int m = 0; m < 4; ++m)
#pragma unroll
                    for (int n = 0; n < 2; ++n) acc[a][b][m][n] = (f32x4){0.f, 0.f, 0.f, 0.f};
        cur = nxt; cA = nA; cB = nB; ++ui;
        if constexpr (ALIGN_EPI) { if (wr == 1) PG8_BAR; }
    }
    PG8_WAIT_V(0);
    if constexpr (!ALIGN_EPI) { if (wr == 0) PG8_BAR; }
    PG8_BAR;
    if constexpr (Epi::AFTER_DRAIN) { E.fused(acc, cur, wr, wc, fr, fq, lds, wid, lane); S.done(cur); }
#undef PG8_SA
#undef PG8_SB
#undef PG8_STAGE
#undef PG8_LDA
#undef PG8_LDB
#undef PG8_MMA
#undef PG8_WAIT_V
#undef PG8_WAIT_L
#undef PG8_BAR
#undef PG8_SCHED
}
}

#define GAS __attribute__((address_space(1)))
#define LAS __attribute__((address_space(3)))
typedef unsigned short bf16;
typedef unsigned v4u __attribute__((ext_vector_type(4)));
typedef unsigned v2u __attribute__((ext_vector_type(2)));
typedef float f32x4 __attribute__((ext_vector_type(4)));
typedef float f32x16 __attribute__((ext_vector_type(16)));
typedef short bf16x8 __attribute__((ext_vector_type(8)));
#define LDS_WAIT() asm volatile("s_waitcnt lgkmcnt(0)" ::: "memory")

struct Args { const void* in[16]; float* out; unsigned char* ws; int ph_lo, ph_hi; };

struct Frame {
    LAS unsigned char* lds; unsigned char* ws; int tid, lane, wave, G, gw, NGW;
};
#define IN_X(a)        ((const float*)(a).in[0])
#define IN_POS(a)      ((const int*)(a).in[1])
#define IN_ATTN_NORM(a) ((const float*)(a).in[2])
#define IN_W_IN(a)     ((const float*)(a).in[3])
#define IN_B_FORGET(a) ((const float*)(a).in[4])
#define IN_QNF(a)      ((const float*)(a).in[5])
#define IN_KNF(a)      ((const float*)(a).in[6])
#define IN_QND(a)      ((const float*)(a).in[7])
#define IN_KND(a)      ((const float*)(a).in[8])
#define IN_W_UP_FOX(a) ((const float*)(a).in[9])
#define IN_W_UP_SB(a)  ((const float*)(a).in[10])
#define IN_W_UP_DIL(a) ((const float*)(a).in[11])
#define IN_W_OUT(a)    ((const float*)(a).in[12])
#define IN_MLP_NORM(a) ((const float*)(a).in[13])
#define IN_W_MLP_IN(a) ((const float*)(a).in[14])
#define IN_W_MLP_OUT(a) ((const float*)(a).in[15])
__device__ __forceinline__ unsigned f2bf(float f) { unsigned u = __builtin_bit_cast(unsigned, f); return (u + 0x7fffu + ((u >> 16) & 1u)) >> 16; }
typedef float f32x2_t __attribute__((ext_vector_type(2))); typedef __bf16 bf16x2_t __attribute__((ext_vector_type(2)));
__device__ __forceinline__ unsigned cvtpk(float lo, float hi) { f32x2_t v = {lo, hi}; bf16x2_t b = __builtin_convertvector(v, bf16x2_t); return __builtin_bit_cast(unsigned, b); }
__device__ __forceinline__ unsigned pk2(float lo, float hi) { return cvtpk(lo, hi); }
__device__ __forceinline__ float blo(unsigned w) { return __uint_as_float(w << 16); }
__device__ __forceinline__ float bhi(unsigned w) { return __uint_as_float(w & 0xffff0000u); }
__device__ __forceinline__ float wave_sum(float v) {
#pragma unroll
    for (int o = 1; o < 64; o <<= 1) v += __shfl_xor(v, o);
    return v;
}

__device__ __forceinline__ void tr_item(const float* W, int pitch, int K, bf16* WT, int nblk, float scale, LAS float* scr, int item, int lane, bool perm = false) {
    const int kb = item / nblk, nb = item % nblk, k0 = 64 * kb, n0 = 32 * nb;
    const int s0 = perm ? (n0 & ~255) + ((n0 >> 5) & 3) * 64 + ((n0 >> 7) & 1) * 32 : n0;
#pragma unroll 8
    for (int i = 0; i < 32; ++i) { const int kk = 2 * i + (lane >> 5); scr[kk * 33 + (lane & 31)] = W[(size_t)(k0 + kk) * pitch + s0 + (lane & 31)]; }
    LDS_WAIT(); asm volatile("" ::: "memory");
    const int c = lane & 7;
#pragma unroll
    for (int j = 0; j < 4; ++j) { const int n = (lane >> 3) + 8 * j; const LAS float* s = scr + (8 * c) * 33 + n;
        v4u o; o.x = pk2(s[0 * 33] * scale, s[1 * 33] * scale); o.y = pk2(s[2 * 33] * scale, s[3 * 33] * scale); o.z = pk2(s[4 * 33] * scale, s[5 * 33] * scale); o.w = pk2(s[6 * 33] * scale, s[7 * 33] * scale);
        *(v4u*)(WT + (size_t)(n0 + n) * K + k0 + 8 * c) = o; }
    LDS_WAIT(); asm volatile("" ::: "memory");
}
__device__ __forceinline__ void p0_prologue(const Frame& F, const Args& A) {
    LAS float* scr = (LAS float*)(F.lds + F.wave * 16384);
    if (blockIdx.x == 0 && F.tid < DEPTH) ((unsigned*)(F.ws + WS_CTL))[F.tid * 64] = 0u;
    for (int it = F.gw; it < DEPTH * ITEMS_PER_LAYER; it += F.NGW) {
        const int layer = it / ITEMS_PER_LAYER; int r = it % ITEMS_PER_LAYER;
        unsigned char* wl = F.ws + WS_W + (size_t)layer * WL_STRIDE;
        const float* win = IN_W_IN(A) + (size_t)layer * DMODEL * DIN;
        bf16* wq = (bf16*)(wl + WL_QKV);
        if (r < 512) { tr_item(win, DIN, 1024, wq, 32, 1.f, scr, r, F.lane, true); continue; } r -= 512;
        if (r < 256) { tr_item(win + 1024, DIN, 1024, wq + (size_t)1024 * 1024, 16, 1.f, scr, r, F.lane); continue; } r -= 256;
        if (r < 256) { tr_item(win + 1544, DIN, 1024, wq + (size_t)1536 * 1024, 16, C2, scr, r, F.lane, true); continue; } r -= 256;
        if (r < 256) { tr_item(win + 2056, DIN, 1024, wq + (size_t)2048 * 1024, 16, 1.f, scr, r, F.lane, true); continue; } r -= 256;
        if (r < 256) { tr_item(win + 2568, DIN, 1024, wq + (size_t)2560 * 1024, 16, 1.f, scr, r, F.lane); continue; } r -= 256;
        if (r < 768) { tr_item(win + 3080, DIN, 1024, wq + (size_t)3072 * 1024, 48, 1.f, scr, r, F.lane, true); continue; } r -= 768;
        if (r < 384) { tr_item(win + 4616, DIN, 1024, wq + (size_t)4608 * 1024, 24, 1.f, scr, r, F.lane); continue; } r -= 384;
        if (r < 1536) { tr_item(win + 5384, DIN, 1024, (bf16*)(wl + WL_G), 96, 1.f, scr, r, F.lane); continue; } r -= 1536;
        if (r < 256) { tr_item(IN_W_UP_FOX(A) + (size_t)layer * 512 * 1024, 1024, 512, (bf16*)(wl + WL_A), 32, 1.f, scr, r, F.lane); continue; } r -= 256;
        if (r < 256) { tr_item(IN_W_UP_SB(A) + (size_t)layer * 512 * 1024, 1024, 512, (bf16*)(wl + WL_B), 32, 1.f, scr, r, F.lane); continue; } r -= 256;
        if (r < 128) { tr_item(IN_W_UP_DIL(A) + (size_t)layer * 256 * 1024, 1024, 256, (bf16*)(wl + WL_C), 32, 1.f, scr, r, F.lane); continue; } r -= 128;
        if (r < 512) { tr_item(IN_W_OUT(A) + (size_t)layer * 1024 * 1024, 1024, 1024, (bf16*)(wl + WL_O), 32, 1.f, scr, r, F.lane); continue; } r -= 512;
        if (r < 2048) { tr_item(IN_W_MLP_IN(A) + (size_t)layer * 1024 * 4096, 4096, 1024, (bf16*)(wl + WL_MI), 128, 1.f, scr, r, F.lane); continue; } r -= 2048;
        tr_item(IN_W_MLP_OUT(A) + (size_t)layer * 4096 * 1024, 1024, 4096, (bf16*)(wl + WL_MO), 32, 1.f, scr, r, F.lane);
    }
    bf16* XN = (bf16*)(F.ws + WS_R0); float* SSQ = (float*)(F.ws + WS_SSQ);
    for (int m = F.gw; m < M; m += F.NGW) {
        const f32x4* xr = (const f32x4*)(IN_X(A) + (size_t)m * DMODEL) + F.lane; const f32x4* gr = (const f32x4*)IN_ATTN_NORM(A) + F.lane;
        unsigned long long* o8 = (unsigned long long*)(XN + (size_t)m * DMODEL) + F.lane; float s = 0.f;
#pragma unroll
        for (int j = 0; j < 4; ++j) { const f32x4 v = xr[64 * j], g = gr[64 * j]; s += (v.x * v.x + v.y * v.y) + (v.z * v.z + v.w * v.w);
            o8[64 * j] = (unsigned long long)pk2(v.x * g.x, v.y * g.y) | ((unsigned long long)pk2(v.z * g.z, v.w * g.w) << 32); }
        s = wave_sum(s);
        if (F.lane < 16) SSQ[(size_t)m * 16 + F.lane] = F.lane == 0 ? s : 0.f;
    }
    if (F.gw == 0) { float* GN = (float*)(F.ws + WS_GAIN);
        for (int l = 0; l < DEPTH; ++l) { GN[l * 256 + F.lane] = IN_QNF(A)[l * 64 + F.lane]; GN[l * 256 + 64 + F.lane] = IN_KNF(A)[l * 64 + F.lane]; GN[l * 256 + 128 + F.lane] = IN_QND(A)[l * 64 + F.lane]; GN[l * 256 + 192 + F.lane] = IN_KND(A)[l * 64 + F.lane]; } }
    { float* COS = (float*)(F.ws + WS_COS); float* SIN = (float*)(F.ws + WS_SIN);
      for (int idx = F.gw * 64 + F.lane; idx < M * 32; idx += F.NGW * 64) { const int mrow = idx >> 5, i = idx & 31;
          const float a = (float)IN_POS(A)[mrow] * exp2f(-(float)i * (13.287712379549449f / 32.0f)); float sn, cs; sincosf(a, &sn, &cs); COS[idx] = cs; SIN[idx] = sn; } }
}

__device__ __forceinline__ void p1_forget(const Frame& F, const Args& A, int layer) {
    LAS bf16* wfb = (LAS bf16*)F.lds;
    LAS float* lfb = (LAS float*)(F.lds + 32768);
    const float* win = IN_W_IN(A) + (size_t)layer * DMODEL * DIN;
    if (blockIdx.x == 0 && F.tid < 3) ((unsigned*)(F.ws + WS_CTL))[F.tid == 0 ? layer * 64 : F.tid == 1 ? layer * 64 + 16 : 32] = 0u;
    const int G_ = (int)gridDim.x, rem_ = ((M / 256) * (NQKV / 256)) % G_;
    const int c0_ = rem_ == 0 ? (int)blockIdx.x : (int)blockIdx.x - rem_, cs_ = rem_ == 0 ? G_ : G_ - rem_;
    if (c0_ < 0) return;
    for (int idx = F.tid; idx < 8192; idx += 512) { const int k = idx >> 3, j = idx & 7; wfb[j * 1056 + k] = (bf16)f2bf(win[(size_t)k * DIN + 1536 + j]); }
    __syncthreads();
    const int lane = F.lane;
    const float bfor = IN_B_FORGET(A)[layer * 8 + (lane & 7)];
    const bf16* XN = (const bf16*)(F.ws + WS_R0); const float* SSQ = (const float*)(F.ws + WS_SSQ);
    float* LFS = (float*)(F.ws + WS_LFS); float* CTOT = (float*)(F.ws + WS_CTOT);
    for (int chunk = c0_; chunk < M / 128; chunk += cs_) {
        {
            typedef float f32x4m __attribute__((ext_vector_type(4)));
            const size_t row0 = (size_t)chunk * 128 + F.wave * 16; const int mr = lane & 15, kg = lane >> 4;
            const bf16* xa = XN + (row0 + mr) * DMODEL + 8 * kg; const LAS bf16* wb = wfb + (mr & 7) * 1056 + 8 * kg;
            f32x4m acc = {0.f, 0.f, 0.f, 0.f};
#pragma unroll 4
            for (int s = 0; s < 32; ++s) { const bf16x8 af = *(const bf16x8*)(xa + 32 * s); bf16x8 bfr = *(const LAS bf16x8*)(wb + 32 * s);
                if (mr >= 8) bfr = (bf16x8){0, 0, 0, 0, 0, 0, 0, 0};
                acc = __builtin_amdgcn_mfma_f32_16x16x32_bf16(af, bfr, acc, 0, 0, 0); }
            if (mr < 8) {
#pragma unroll
                for (int r = 0; r < 4; ++r) { const int rr = 4 * kg + r; const float y = acc[r] * pg8::row_rstd(SSQ, (int)(row0 + rr)) + bfor;
                    lfb[(F.wave * 16 + rr) * 8 + mr] = -(fmaxf(-y, 0.f) + log1pf(expf(-fabsf(y)))); } }
        }
        __syncthreads();
        if (F.wave == 0) {
            const int j = lane & 7, seg = lane >> 3; float run = 0.f;
#pragma unroll
            for (int i = 0; i < 16; ++i) { run += lfb[(seg * 16 + i) * 8 + j]; lfb[(seg * 16 + i) * 8 + j] = run; }
            float off = 0.f;
#pragma unroll
            for (int s = 1; s < 8; ++s) { const float o = __shfl_up(run, 8 * s); if (seg >= s) off += o; }
            const int b = chunk >> 4, t0 = (chunk & 15) * 128 + seg * 16;
#pragma unroll
            for (int i = 0; i < 16; ++i) LFS[((size_t)(b * 8 + j)) * 2048 + t0 + i] = lfb[(seg * 16 + i) * 8 + j] + off;
            if (seg == 7) CTOT[chunk * 8 + j] = off + run;
        }
        __syncthreads();
    }
}

template <int KIND> __device__ __forceinline__ void coop_block(const Frame& F, const float* gq_, const float* gk_, int b, int hh, int lg, int c, int QB) {
    const int tid = F.tid, lane = F.lane, w = F.wave, q = lane & 31, hi = lane >> 5;
    constexpr int H = KIND == 2 ? 12 : 8, pitch = KIND == 2 ? 768 : 512;
    bf16* Qp = (bf16*)(F.ws + (KIND == 0 ? WS_SBQ : KIND == 1 ? WS_FOXQ : WS_DILQ));
    const bf16* Kp = (const bf16*)(F.ws + (KIND == 0 ? WS_SBK : KIND == 1 ? WS_FOXK : WS_DILK));
    const bf16* Vt = (const bf16*)(F.ws + (KIND == 0 ? WS_SBV : KIND == 1 ? WS_FOXV : WS_DILV));
    const int Ls_ = 2048 >> lg, NTS = Ls_ >> 5;
    const int qt = 8 * QB + w; const bool wave_on = qt < NTS;
    const int base = 8 * QB, TMAX = (base + 7 < NTS - 1) ? base + 7 : NTS - 1;
    const int tq = c + ((32 * (wave_on ? qt : 0) + q) << lg);
    bf16* qrow = Qp + ((size_t)b * 2048 + tq) * pitch + hh * 64;
    bf16x8 qf[4];
#pragma unroll
    for (int d0 = 0; d0 < 4; ++d0) qf[d0] = *(const bf16x8*)(qrow + 16 * d0 + 8 * hi);
    const bool ldk = tid < 256; const int t2 = tid & 255;
    const int ki = t2 >> 3, kch = t2 & 7, kpi = (ki & 19) | ((ki & 4) << 1) | ((ki & 8) >> 1);
    const int vd = t2 >> 2, vc = t2 & 3;
    const bf16* gsrc = ldk ? Kp + ((size_t)(b * H + hh) * 2048 + c * Ls_ + kpi) * 64 + 8 * kch : Vt + ((size_t)(b * H + hh) * 64 + (c * Ls_ >> 5)) * 2048 + vd * 32 + 8 * vc;
    const int ldst = ldk ? ki * 128 + ((kch ^ ((ki >> 1) & 7)) << 4) : 49152 + vd * 64 + ((vc ^ ((vd >> 2) & 3)) << 4);
    int koff[4], voff[2][2];
#pragma unroll
    for (int d0 = 0; d0 < 4; ++d0) koff[d0] = q * 128 + (((2 * d0 + hi) ^ ((q >> 1) & 7)) << 4);
#pragma unroll
    for (int dh = 0; dh < 2; ++dh)
#pragma unroll
        for (int s2 = 0; s2 < 2; ++s2) { const int d = q + 32 * dh; voff[dh][s2] = 49152 + d * 64 + (((2 * s2 + hi) ^ ((d >> 2) & 3)) << 4); }
    float offs = 0.f; const float* lfrow = nullptr; f32x4 bs[4]; float Bq = 0.f;
    if (KIND == 1) {
        float gq = fabsf(gq_[lane]), gk = fabsf(gk_[lane]);
#pragma unroll
        for (int o = 1; o < 64; o <<= 1) { gq = fmaxf(gq, __shfl_xor(gq, o)); gk = fmaxf(gk, __shfl_xor(gk, o)); }
        Bq = 64.f * C2 * gq * gk * 1.02f + 0.01f; }
    if (KIND == 1) { const float ct = lane < 16 ? ((const float*)(F.ws + WS_CTOT))[(b * 16 + lane) * 8 + hh] : 0.f; float inc = ct;
#pragma unroll
        for (int o = 1; o < 16; o <<= 1) { const float t = __shfl_up(inc, o); if (lane >= o) inc += t; }
        offs = inc - ct;
        lfrow = (const float*)(F.ws + WS_LFS) + (size_t)(b * 8 + hh) * 2048 + 8 * hi;
#pragma unroll
        for (int g = 0; g < 4; ++g) bs[g] = *(const f32x4*)(lfrow + 32 * qt + 16 * (g >> 1) + 4 * (g & 1)); }
    f32x16 o0, o1;
#pragma unroll
    for (int r = 0; r < 16; ++r) { o0[r] = 0.f; o1[r] = 0.f; }
    float m = -1e30f, lsum = 0.f, carry = 0.f; bool done = !wave_on;
    LAS unsigned char* L = F.lds; LAS int* flg = (LAS int*)(L + 98304);
#define NEW_TILE(I) (KIND == 2 ? base + 3 + (I) : base - (I))
#define NEW_OK(I) (KIND == 2 ? ((I) <= 4 && NEW_TILE(I) <= TMAX) : (NEW_TILE(I) >= 0))
    { v4u r8[8]; const int f0 = KIND == 2 ? base - 4 : base;
#pragma unroll
      for (int k = 0; k < 8; ++k) { const int tl = f0 + k; if (tl >= 0 && tl <= TMAX) r8[k] = *(const v4u*)(gsrc + (size_t)2048 * tl); }
#pragma unroll
      for (int k = 0; k < 8; ++k) { const int tl = f0 + k; if (tl >= 0 && tl <= TMAX) *(LAS v4u*)(L + 4096 * (tl % 12) + ldst) = r8[k]; } }
    v4u rS = (v4u){0u, 0u, 0u, 0u};
    if (NEW_OK(1)) rS = *(const v4u*)(gsrc + (size_t)2048 * NEW_TILE(1));
    __syncthreads();
    const int NI = KIND == 2 ? 5 : base + 8;
    for (int j = 0; j < NI; ++j) {
        if (NEW_OK(j + 1)) *(LAS v4u*)(L + 4096 * (NEW_TILE(j + 1) % 12) + ldst) = rS;
        if (NEW_OK(j + 2)) rS = *(const v4u*)(gsrc + (size_t)2048 * NEW_TILE(j + 2));
        const int t = KIND == 2 ? qt - 4 + j : qt - j;
        if (KIND != 2 && t < 0) done = true;
        const bool act = wave_on && t >= 0 && (KIND == 2 || !done);
        if (act) {
            const LAS unsigned char* Ls = L + 4096 * (t % 12);
            f32x16 s;
            float bnd = 0.f;
            if (KIND == 1) { const float off = __builtin_bit_cast(float, __builtin_amdgcn_readlane(__builtin_bit_cast(int, offs), t >> 2));
                bnd = Bq - (__builtin_bit_cast(float, __builtin_amdgcn_readlane(__builtin_bit_cast(int, bs[0].x), 0)) + off) * LOG2E;
#pragma unroll
                for (int g = 0; g < 4; ++g) { const f32x4 f = bs[g];
                    s[4 * g] = -(f.x + off) * LOG2E; s[4 * g + 1] = -(f.y + off) * LOG2E; s[4 * g + 2] = -(f.z + off) * LOG2E; s[4 * g + 3] = -(f.w + off) * LOG2E; }
                if (t > 0) {
#pragma unroll
                    for (int g = 0; g < 4; ++g) bs[g] = *(const f32x4*)(lfrow + 32 * (t - 1) + 16 * (g >> 1) + 4 * (g & 1)); }
            } else {
#pragma unroll
                for (int r = 0; r < 16; ++r) s[r] = 0.f;
            }
#pragma unroll
            for (int d0 = 0; d0 < 4; ++d0) { const bf16x8 kf = *(const LAS bf16x8*)(Ls + koff[d0]); s = __builtin_amdgcn_mfma_f32_32x32x16_bf16(kf, qf[d0], s, 0, 0, 0); }
            float p[16];
            if (KIND == 0) {
                float ln[16];
#pragma unroll
                for (int r = 0; r < 16; ++r) { const float z = s[r]; ln[r] = -(fmaxf(z, 0.f) + __builtin_amdgcn_logf(1.f + __builtin_amdgcn_exp2f(-fabsf(z)))); }
                if (t == qt) {
#pragma unroll
                    for (int r = 0; r < 16; ++r) if (16 * (r >> 3) + 8 * hi + (r & 7) >= q) ln[r] = 0.f;
                }
                float S0 = 0.f, S1 = 0.f;
#pragma unroll
                for (int e = 0; e < 8; ++e) { S0 += ln[e]; S1 += ln[8 + e]; }
                const float X0 = __shfl_xor(S0, 32), X1 = __shfl_xor(S1, 32);
                float run0 = carry + X1 + S1 + (hi == 0 ? X0 : 0.f), run1 = carry + (hi == 0 ? X1 : 0.f);
#pragma unroll
                for (int e = 7; e >= 0; --e) { run0 += ln[e]; p[e] = __builtin_amdgcn_exp2f(s[e] + run0); run1 += ln[8 + e]; p[8 + e] = __builtin_amdgcn_exp2f(s[8 + e] + run1); }
                if (t == qt) {
#pragma unroll
                    for (int r = 0; r < 16; ++r) if (16 * (r >> 3) + 8 * hi + (r & 7) >= q) p[r] = 0.f;
                }
                carry += (S0 + S1) + (X0 + X1);
                if (__all(carry < -160.f) || t == 0) done = true;
            } else {
                if (t == qt) {
#pragma unroll
                    for (int r = 0; r < 16; ++r) if (16 * (r >> 3) + 8 * hi + (r & 7) > q) s[r] = -1e30f;
                }
                if (KIND == 2 && t + 4 == qt) {
#pragma unroll
                    for (int r = 0; r < 16; ++r) if (16 * (r >> 3) + 8 * hi + (r & 7) < q) s[r] = -1e30f;
                }
                float tm = s[0];
#pragma unroll
                for (int r = 1; r < 16; ++r) tm = fmaxf(tm, s[r]);
                tm = fmaxf(tm, __shfl_xor(tm, 32));
                const float mn = fmaxf(m, tm), alpha = __builtin_amdgcn_exp2f(m - mn); m = mn;
                float ps = 0.f;
#pragma unroll
                for (int r = 0; r < 16; ++r) { p[r] = __builtin_amdgcn_exp2f(s[r] - mn); ps += p[r]; }
                lsum = lsum * alpha + ps;
#pragma unroll
                for (int r = 0; r < 16; ++r) { o0[r] *= alpha; o1[r] *= alpha; }
                if (KIND == 1 && (__all(bnd - m < -150.f) || t == 0)) done = true;
            }
            v4u w0, w1; w0.x = cvtpk(p[0], p[1]); w0.y = cvtpk(p[2], p[3]); w0.z = cvtpk(p[4], p[5]); w0.w = cvtpk(p[6], p[7]);
            w1.x = cvtpk(p[8], p[9]); w1.y = cvtpk(p[10], p[11]); w1.z = cvtpk(p[12], p[13]); w1.w = cvtpk(p[14], p[15]);
            const bf16x8 pb0 = __builtin_bit_cast(bf16x8, w0), pb1 = __builtin_bit_cast(bf16x8, w1);
            { const bf16x8 v00 = *(const LAS bf16x8*)(Ls + voff[0][0]), v01 = *(const LAS bf16x8*)(Ls + voff[0][1]), v10 = *(const LAS bf16x8*)(Ls + voff[1][0]), v11 = *(const LAS bf16x8*)(Ls + voff[1][1]);
              o0 = __builtin_amdgcn_mfma_f32_32x32x16_bf16(v00, pb0, o0, 0, 0, 0); o0 = __builtin_amdgcn_mfma_f32_32x32x16_bf16(v01, pb1, o0, 0, 0, 0);
              o1 = __builtin_amdgcn_mfma_f32_32x32x16_bf16(v10, pb0, o1, 0, 0, 0); o1 = __builtin_amdgcn_mfma_f32_32x32x16_bf16(v11, pb1, o1, 0, 0, 0); }
        }
        if (KIND != 2) { if (lane == 0) flg[(j & 1) * 8 + w] = done ? 0 : 1; }
        __syncthreads();
        if (KIND != 2) { const LAS int* fp = flg + (j & 1) * 8; const int any = fp[0] | fp[1] | fp[2] | fp[3] | fp[4] | fp[5] | fp[6] | fp[7]; if (any == 0) break; }
    }
#undef NEW_TILE
#undef NEW_OK
    if (wave_on) {
        float inv = 1.0f;
        if (KIND != 0) { lsum += __shfl_xor(lsum, 32); inv = 1.0f / lsum;
            if (KIND == 2 && hi == 0) ((float*)(F.ws + WS_LSE))[((size_t)b * 2048 + tq) * 12 + hh] = m + __builtin_amdgcn_logf(lsum); }
#pragma unroll
        for (int g = 0; g < 4; ++g) { v2u a; a.x = cvtpk(o0[4 * g] * inv, o0[4 * g + 1] * inv); a.y = cvtpk(o0[4 * g + 2] * inv, o0[4 * g + 3] * inv); *(v2u*)(qrow + 8 * g + 4 * hi) = a;
            v2u bq; bq.x = cvtpk(o1[4 * g] * inv, o1[4 * g + 1] * inv); bq.y = cvtpk(o1[4 * g + 2] * inv, o1[4 * g + 3] * inv); *(v2u*)(qrow + 32 + 8 * g + 4 * hi) = bq; }
    }
    __syncthreads();
}
constexpr int N_Q_UNITS = 1024 + 1024 + 512 + 512 + 1024;
__device__ __forceinline__ void p3_attention(const Frame& F, const Args& A, int layer) {
    const float* gq_ = IN_QNF(A) + layer * 64; const float* gk_ = IN_KNF(A) + layer * 64;
    unsigned* ctr = (unsigned*)(F.ws + WS_CTL) + layer * 64;
    LAS unsigned* uq = (LAS unsigned*)(F.lds + 98304 + 128);
    if (F.tid == 0) uq[0] = atomicAdd(ctr, 1u);
    __syncthreads();
    unsigned u = uq[0];
    for (;;) {
        if (u >= (unsigned)N_Q_UNITS) break;
        unsigned nxtu = 0u; if (F.tid == 0) nxtu = atomicAdd(ctr, 1u);
        if (u < 1024u) { const int QB = 7 - (int)(u >> 7), bh = u & 127; coop_block<1>(F, gq_, gk_, bh >> 3, bh & 7, 0, 0, QB); }
        else if (u < 2048u) { const int d = u - 1024; const int QB = 7 - (d >> 7), bh = d & 127; coop_block<0>(F, nullptr, nullptr, bh >> 3, bh & 7, 0, 0, QB); }
        else if (u < 2560u) { const int d = u - 2048; const int QB = 7 - (d >> 6), bj = d & 63; coop_block<2>(F, nullptr, nullptr, bj >> 2, bj & 3, 0, 0, QB); }
        else if (u < 3072u) { const int d = u - 2560; const int half = 1 - (d >> 8), r = d & 255; coop_block<2>(F, nullptr, nullptr, r >> 4, 4 + ((r >> 2) & 3), 2, r & 3, half); }
        else { const int d = u - 3072; coop_block<2>(F, nullptr, nullptr, d >> 6, 8 + ((d >> 4) & 3), 4, d & 15, 0); }
        if (F.tid == 0) uq[0] = nxtu;
        __syncthreads();
        u = uq[0];
    }
}
__device__ __forceinline__ void p4_combine(const Frame& F) {
    const float* LSE = (const float*)(F.ws + WS_LSE); const bf16* O = (const bf16*)(F.ws + WS_DILQ); bf16* OC = (bf16*)(F.ws + WS_OC);
    for (int pair = F.gw; pair < M / 2; pair += F.NGW) {
        const size_t tok = (size_t)2 * pair + (F.lane >> 5); const int sub = F.lane & 31, j = sub >> 3, d0 = (sub & 7) * 8;
        const float l0 = LSE[tok * 12 + j], l1 = LSE[tok * 12 + 4 + j], l2 = LSE[tok * 12 + 8 + j]; const float mx = fmaxf(l0, fmaxf(l1, l2));
        float w0 = __builtin_amdgcn_exp2f(l0 - mx), w1 = __builtin_amdgcn_exp2f(l1 - mx), w2 = __builtin_amdgcn_exp2f(l2 - mx); const float inv = 1.0f / (w0 + w1 + w2); w0 *= inv; w1 *= inv; w2 *= inv;
        const v4u a = *(const v4u*)(O + tok * 768 + j * 64 + d0), bq = *(const v4u*)(O + tok * 768 + (4 + j) * 64 + d0), cq = *(const v4u*)(O + tok * 768 + (8 + j) * 64 + d0);
        v4u o;
        o.x = pk2(w0 * blo(a.x) + w1 * blo(bq.x) + w2 * blo(cq.x), w0 * bhi(a.x) + w1 * bhi(bq.x) + w2 * bhi(cq.x));
        o.y = pk2(w0 * blo(a.y) + w1 * blo(bq.y) + w2 * blo(cq.y), w0 * bhi(a.y) + w1 * bhi(bq.y) + w2 * bhi(cq.y));
        o.z = pk2(w0 * blo(a.z) + w1 * blo(bq.z) + w2 * blo(cq.z), w0 * bhi(a.z) + w1 * bhi(bq.z) + w2 * bhi(cq.z));
        o.w = pk2(w0 * blo(a.w) + w1 * blo(bq.w) + w2 * blo(cq.w), w0 * bhi(a.w) + w1 * bhi(bq.w) + w2 * bhi(cq.w));
        *(v4u*)(OC + tok * 256 + j * 64 + d0) = o;
    }
}


__device__ const int PROG[] = {0, 1, 3, 4, 5, 6, 7, 8, 9, 11, 12, 13, 14, 15, 16};
constexpr int NPROG = sizeof(PROG) / sizeof(int);
typedef GAS unsigned gu32;
#define XB_TMO      128
#define XB_XCNT(j)  (256  + 64 * (j))
#define XB_XSUB(j)  (1280 + 64 * (j))
#define XB_XGEN(j)  (2304 + 64 * (j))
#define XB_TOP      3328
#define XB_TOPGEN   3392
#define XCD_BAR_WORDS 3456
#define XB_SPIN_CAP (1u << 18)

__device__ __forceinline__ unsigned xb_ld(unsigned* p)              { return __hip_atomic_load(p, __ATOMIC_RELAXED, __HIP_MEMORY_SCOPE_AGENT); }
__device__ __forceinline__ unsigned xb_add(unsigned* p, unsigned v) { return __hip_atomic_fetch_add(p, v, __ATOMIC_RELAXED, __HIP_MEMORY_SCOPE_AGENT); }
__device__ __forceinline__ unsigned xb_xcc_id() { return (unsigned)__builtin_amdgcn_s_getreg((3 << 11) | 20) & 0xFu; }
#define XB_SPIN(cond, bar) do { unsigned _sp = 0; while (cond) { __builtin_amdgcn_s_sleep(1); \
    if ((++_sp & 255u) == 0u) { if (xb_ld(&(bar)[XB_TMO])) break; if (_sp > XB_SPIN_CAP) { atomicAdd(&(bar)[XB_TMO], 1u); break; } } } } while (0)

struct XcdBarrier {
    unsigned* bar; unsigned x;
    volatile LAS unsigned* st;
};

__device__ __forceinline__ XcdBarrier xcd_barrier_post(unsigned* bar, volatile LAS unsigned* st) {
    XcdBarrier b; b.bar = bar; b.x = xb_xcc_id(); b.st = st;
    if (threadIdx.x == 0) (void)xb_add(&bar[XB_XCNT(b.x)], 1u);
    return b;
}
__device__ __forceinline__ void xcd_barrier_complete(unsigned* bar, unsigned x, unsigned& nloc, unsigned& nx) {
    const unsigned G = gridDim.x * gridDim.y * gridDim.z;
    unsigned sum, cnt, mine, sp = 0u;
    for (;;) {
        sum = 0u; cnt = 0u; mine = 0u;
#pragma unroll
        for (unsigned j = 0; j < 16; ++j) { const unsigned c = xb_ld(&bar[XB_XCNT(j)]); sum += c; cnt += (c > 0u) ? 1u : 0u; mine = (j == x) ? c : mine; }
        if (sum == G) break;
        __builtin_amdgcn_s_sleep(1);
        if ((++sp & 255u) == 0u) { if (xb_ld(&bar[XB_TMO])) break; if (sp > XB_SPIN_CAP) { atomicAdd(&bar[XB_TMO], 1u); break; } }
    }
    nloc = mine > 0u ? mine : 1u; nx = cnt > 0u ? cnt : 1u;
}

__device__ __forceinline__ void xcd_barrier(const XcdBarrier& b, bool leader  ) {
    asm volatile("s_waitcnt vmcnt(0)" ::: "memory");
    __syncthreads();
    if (leader) {
        unsigned* bar = b.bar;
        __builtin_amdgcn_s_waitcnt(0);
        unsigned nloc = b.st[0], nx = b.st[1];
        if (nloc == 0u) { xcd_barrier_complete(bar, b.x, nloc, nx); b.st[0] = nloc; b.st[1] = nx; }
        const unsigned old = xb_add(&bar[XB_XSUB(b.x)], 1u);
        const unsigned gen = old / nloc;
        if (old + 1u == (gen + 1u) * nloc) {
            __builtin_amdgcn_fence(__ATOMIC_RELEASE, "agent");
            asm volatile("s_waitcnt vmcnt(0)" ::: "memory");
            const unsigned og = xb_add(&bar[XB_TOP], 1u);
            const unsigned tg = og / nx;
            if (og + 1u == (tg + 1u) * nx) xb_add(&bar[XB_TOPGEN], 1u);
            else XB_SPIN(xb_ld(&bar[XB_TOPGEN]) == tg, bar);
            __builtin_amdgcn_fence(__ATOMIC_ACQUIRE, "agent");
            xb_add(&bar[XB_XGEN(b.x)], 1u);
            asm volatile("s_waitcnt vmcnt(0)" ::: "memory");
        } else {
            XB_SPIN(xb_ld(&bar[XB_XGEN(b.x)]) == gen, bar);
            __builtin_amdgcn_fence(__ATOMIC_ACQUIRE, "agent");
            asm volatile("s_waitcnt vmcnt(0)" ::: "memory");
        }
    }
    __syncthreads();
}

constexpr int RT_OFF = 131072, RT_MAX_UNITS = 15;
__device__ __forceinline__ void fill_rstd(const Frame& F, const pg8::StaticOrder& S, const float* SSQ) {
    LAS float* rt = (LAS float*)(F.lds + RT_OFF); LAS int* pmt = (LAS int*)(F.lds + RT_OFF + RT_MAX_UNITS * 1024);
    if (F.tid < RT_MAX_UNITS) { pg8::Unit u; pmt[F.tid] = S.next(F.tid, u) ? u.pm : -1; }
    __syncthreads();
    const int rl = F.tid >> 1, hf = F.tid & 1;
    f32x4 a[RT_MAX_UNITS], b[RT_MAX_UNITS];
#pragma unroll
    for (int i = 0; i < RT_MAX_UNITS; ++i) { const int pm = pmt[i]; const f32x4* p = (const f32x4*)(SSQ + (size_t)((pm < 0 ? 0 : pm) * 256 + rl) * 16 + 8 * hf); a[i] = p[0]; b[i] = p[1]; }
#pragma unroll
    for (int i = 0; i < RT_MAX_UNITS; ++i) { float s = ((a[i][0] + a[i][1]) + (a[i][2] + a[i][3])) + ((b[i][0] + b[i][1]) + (b[i][2] + b[i][3])); s += __shfl_xor(s, 1);
        if (hf == 0 && pmt[i] >= 0) rt[i * 256 + rl] = __builtin_amdgcn_rsqf(s * (1.0f / 1024.0f) + EPS); }
    __syncthreads();
}
__global__ void __launch_bounds__(NWAVES * 64, 2) fwd_mega(Args args) {
    extern __shared__ __attribute__((aligned(16))) unsigned char lds[];
    cg::grid_group grid = cg::this_grid();
    const Args& A = args;
    volatile LAS unsigned* xb_st = (volatile LAS unsigned*)((LAS unsigned char*)lds + LDS_BYTES - 64);
    if (threadIdx.x < 2) xb_st[threadIdx.x] = 0u;
    __syncthreads();
    const XcdBarrier xbar = xcd_barrier_post((unsigned*)(args.ws + WS_CTL + 65536), xb_st);
    for (int pi = args.ph_lo; pi < args.ph_hi; ++pi) {
        const int ph = PROG[pi];
        unsigned char* ws = args.ws; asm volatile("" : "+s"(ws));
        const float* SSQ = (const float*)(ws + WS_SSQ);
        int tid_ = threadIdx.x; asm volatile("" : "+v"(tid_));
        Frame F;
        F.lds = (LAS unsigned char*)lds; F.ws = ws;
        F.tid = tid_; F.lane = F.tid & 63; F.wave = __builtin_amdgcn_readfirstlane(F.tid >> 6);
        F.G = gridDim.x; F.gw = blockIdx.x * NWAVES + F.wave; F.NGW = F.G * NWAVES;
        if (ph == 0) { p0_prologue(F, A); }
        else {
            const int layer = (ph - 1) >> 3, sub = (ph - 1) & 7;
            unsigned char* wl = ws + WS_W + (size_t)layer * WL_STRIDE;
            const int bx = (int)blockIdx.x;
            if (sub == 0) {
                pg8::Gemm g{(const bf16*)(ws + WS_R0), (const bf16*)(wl + WL_QKV), M, NQKV, 1024}; pg8::StaticOrder S; S.init(M, NQKV, F.G, bx);
                p1_forget(F, A, layer);
                fill_rstd(F, S, SSQ);
                pg8::EpiQKV E{(const LAS float*)(F.lds + RT_OFF), ws, (const float*)(ws + WS_GAIN) + layer * 256, C2};
                pg8::gemm_phase<pg8::EpiQKV, pg8::StaticOrder, true, true>(F.lds, g, S, E);
            } else if (sub == 1) {
            } else if (sub == 2) { p3_attention(F, A, layer);
            } else if (sub == 3) {
                p4_combine(F);
            } else if (sub == 4) {
                pg8::StaticOrder S; S.init(M, 1024, F.G, bx);
                fill_rstd(F, S, SSQ);
#pragma unroll 1
                for (int br = 0; br < 3; ++br) {
                    { pg8::Gemm g{(const bf16*)(ws + WS_R0), (const bf16*)(wl + WL_G) + (size_t)br * 1024 * 1024, M, 1024, 1024};
                      pg8::EpiAct<0> E{(const LAS float*)(F.lds + RT_OFF), (bf16*)(ws + WS_GATE), 1024};
                      pg8::gemm_phase<pg8::EpiAct<0>, pg8::StaticOrder, true, true>(F.lds, g, S, E); }
                    { const bf16* Ab = (const bf16*)(ws + (br == 0 ? WS_FOXQ : br == 1 ? WS_SBQ : WS_OC)); const bf16* Bb = (const bf16*)(wl + (br == 0 ? WL_A : br == 1 ? WL_B : WL_C));
                      pg8::Gemm g{Ab, Bb, M, 1024, br == 2 ? 256 : 512}; pg8::EpiMerge E{(const bf16*)(ws + WS_GATE), (bf16*)(ws + WS_MRG), br};
                      pg8::gemm_phase<pg8::EpiMerge, pg8::StaticOrder, true, true>(F.lds, g, S, E); }
                }
            } else if (sub == 5) {
                pg8::Gemm g{(const bf16*)(ws + WS_MRG), (const bf16*)(wl + WL_O), M, 1024, 1024}; pg8::StaticOrder S; S.init(M, 1024, F.G, bx);
                pg8::EpiRes E{layer == 0 ? IN_X(A) : A.out, A.out, (bf16*)(ws + WS_R1), IN_MLP_NORM(A) + layer * 1024, (float*)(ws + WS_SSQ)};
                pg8::gemm_phase<pg8::EpiRes, pg8::StaticOrder, true, true>(F.lds, g, S, E);
            } else if (sub == 6) {
                pg8::Gemm g{(const bf16*)(ws + WS_R1), (const bf16*)(wl + WL_MI), M, DFF, 1024}; pg8::StaticOrder S; S.init(M, DFF, F.G, bx);
                fill_rstd(F, S, SSQ);
                pg8::EpiAct<1> E{(const LAS float*)(F.lds + RT_OFF), (bf16*)(ws + WS_HID), DFF};
                pg8::gemm_phase<pg8::EpiAct<1>, pg8::StaticOrder, true, true>(F.lds, g, S, E);
            } else {
                pg8::Gemm g{(const bf16*)(ws + WS_HID), (const bf16*)(wl + WL_MO), M, 1024, DFF}; pg8::StaticOrder S; S.init(M, 1024, F.G, bx);
                const bool last = layer == DEPTH - 1;
                pg8::EpiRes E{A.out, A.out, last ? (bf16*)nullptr : (bf16*)(ws + WS_R0), IN_ATTN_NORM(A) + (last ? 0 : (layer + 1) * 1024), (float*)(ws + WS_SSQ)};
                pg8::gemm_phase<pg8::EpiRes, pg8::StaticOrder, true, true>(F.lds, g, S, E);
            }
        }
        if (pi + 1 < args.ph_hi) {
            if (args.ph_hi > 4096) {
                asm volatile("s_waitcnt vmcnt(0) lgkmcnt(0)" ::: "memory");
                grid.sync();
                __builtin_amdgcn_fence(__ATOMIC_ACQUIRE, "agent");
                asm volatile("s_waitcnt vmcnt(0)" ::: "memory");
            } else xcd_barrier(xbar, F.tid == 0);
        }
    }
}


#ifndef N_LAUNCH_MODE
#define N_LAUNCH_MODE 1
#endif
extern "C" void kernel_launch(void* const* d_in, const int* in_sizes, int n_in, void* d_out, int out_size, void* d_ws, size_t ws_size, hipStream_t stream) {
    static int grid = 0;
    if (grid == 0) {
        if (n_in != 16 || out_size != M * DMODEL || ws_size < WS_END) { fprintf(stderr, "kernel_launch: unexpected shapes (n_in %d out %d ws %zu)\n", n_in, out_size, ws_size); grid = -1; return; }
        int dev = 0, cus = 0, per_cu = 0;
        hipGetDevice(&dev); hipDeviceGetAttribute(&cus, hipDeviceAttributeMultiprocessorCount, dev);
        hipFuncSetAttribute((const void*)fwd_mega, hipFuncAttributeMaxDynamicSharedMemorySize, LDS_BYTES);
        hipOccupancyMaxActiveBlocksPerMultiprocessor(&per_cu, (const void*)fwd_mega, NWAVES * 64, LDS_BYTES);
        if (per_cu < 1) per_cu = 1;
        grid = cus * per_cu;
        (void)hipGetLastError();
    }
    if (grid < 0) return;
    if (hipMemsetAsync((unsigned char*)d_ws + WS_CTL, 0, 131072, stream) != hipSuccess) { fprintf(stderr, "kernel_launch: memset of the control words failed\n"); return; }
    Args a{};
    for (int i = 0; i < 16; ++i) a.in[i] = d_in[i];
    a.out = (float*)d_out; a.ws = (unsigned char*)d_ws;
#if N_LAUNCH_MODE == 1
    a.ph_lo = 0; a.ph_hi = NPROG;
    { void* kargs[] = {&a}; hipError_t e = hipLaunchCooperativeKernel((const void*)fwd_mega, dim3(grid), dim3(NWAVES * 64), kargs, LDS_BYTES, stream);
      if (e != hipSuccess) fprintf(stderr, "cooperative launch failed: %s (grid %d)\n", hipGetErrorString(e), grid); }
#else
    const int nph = NPROG;
    for (int ph = 0; ph < nph; ++ph) { a.ph_lo = ph; a.ph_hi = ph + 1; void* kargs[] = {&a};
        hipError_t e = hipLaunchCooperativeKernel((const void*)fwd_mega, dim3(grid), dim3(NWAVES * 64), kargs, LDS_BYTES, stream);
        if (e != hipSuccess) { fprintf(stderr, "launch %d failed: %s\n", ph, hipGetErrorString(e)); break; } }
#endif
}
```
